# Optimizing an MI355X kernel written in HIP

```python
import jax, jax.numpy as jnp
from jax import lax
import numpy as np

D_MODEL = 1024
BATCH = 2
SEQ = 16384
DEPTH = 2

HEAD_DIM = D_MODEL // 16
RET_HEADS = 4
RET_DK = HEAD_DIM
RET_DV = HEAD_DIM
RET_CHUNK = 128
MLA_HEADS = 4
MLA_NOPE = 2 * HEAD_DIM
MLA_ROPE = HEAD_DIM
MLA_DV = 2 * HEAD_DIM
MLA_Q_RANK = 3 * D_MODEL // 8
MLA_KV_RANK = D_MODEL // 4
MLA_BLOCK = 128
GLA_HEADS = 4
GLA_DK = HEAD_DIM
GLA_DV = HEAD_DIM
GLA_GATE_RANK = 16
GLA_TAU = 16.0
GLA_CHUNK = 128
D_MIX = RET_HEADS * RET_DV + MLA_HEADS * MLA_DV + GLA_HEADS * GLA_DV
IN_SPLITS = (
    RET_HEADS * RET_DK, RET_HEADS * RET_DK, RET_HEADS * RET_DV, RET_HEADS * RET_DV,
    MLA_Q_RANK, MLA_KV_RANK, MLA_ROPE,
    GLA_HEADS * GLA_DK, GLA_HEADS * GLA_DK, GLA_HEADS * GLA_DV, GLA_GATE_RANK,
    GLA_HEADS * GLA_DV,
)
IN_COLS = sum(IN_SPLITS)
D_FF = ((8 * D_MODEL // 3 + 127) // 128) * 128
ROPE_THETA = 10000.0
EPS = 1e-6

kernel_name = "hybrid_retention_mla_gla_macaron"


def rms_norm(x, g):
    xf = x.astype(jnp.float32)
    y = xf * lax.rsqrt(jnp.mean(xf * xf, axis=-1, keepdims=True) + EPS)
    return (y * g.astype(jnp.float32)).astype(x.dtype)


def rope_tables(positions, dim):
    inv = ROPE_THETA ** (-jnp.arange(0, dim, 2, dtype=jnp.float32) / dim)
    ang = positions.astype(jnp.float32)[..., None] * inv
    return jnp.cos(ang), jnp.sin(ang)


def apply_rope(x, cos, sin):
    x1, x2 = jnp.split(x, 2, axis=-1)
    c = cos[:, :, None, :].astype(x.dtype)
    s = sin[:, :, None, :].astype(x.dtype)
    return jnp.concatenate([x1 * c - x2 * s, x1 * s + x2 * c], axis=-1)


def swiglu(x, w_gate_up, w_down):
    g, u = jnp.split(x @ w_gate_up, 2, axis=-1)
    return (jax.nn.silu(g) * u) @ w_down


def to_chunks(x, c):
    b, s, h, d = x.shape
    return x.reshape(b, s // c, c, h, d).transpose(1, 0, 3, 2, 4)


def from_chunks(o):
    n, b, h, c, d = o.shape
    return o.transpose(1, 0, 3, 2, 4).reshape(b, n * c, h * d)


def retention(q, k, v):
    out_dtype = v.dtype
    b, s, h, dk = q.shape
    dv = v.shape[-1]
    c = RET_CHUNK
    q = q.astype(jnp.float32)
    k = k.astype(jnp.float32) * (dk ** -0.5)
    v = v.astype(jnp.float32)
    log_g = jnp.log1p(-jnp.power(2.0, -5.0 - jnp.arange(h, dtype=jnp.float32)))
    idx = jnp.arange(c, dtype=jnp.float32)
    diff = idx[:, None] - idx[None, :]
    intra = jnp.where(diff >= 0, jnp.exp(log_g[:, None, None] * jnp.maximum(diff, 0.0)), 0.0)
    xi = jnp.exp(log_g[:, None] * (idx + 1.0))[:, :, None]
    zeta = jnp.exp(log_g[:, None] * (c - 1.0 - idx))[:, :, None]
    chunk_decay = jnp.exp(log_g * c)[:, None, None]

    def step(state, inp):
        qi, ki, vi = inp
        sc = jnp.einsum('bhtd,bhsd->bhts', qi, ki) * intra
        o = jnp.einsum('bhts,bhsv->bhtv', sc, vi) + jnp.einsum('bhtd,bhdv->bhtv', qi, state) * xi
        state = state * chunk_decay + jnp.einsum('bhsd,bhsv->bhdv', ki, vi * zeta)
        return state, o

    state0 = jnp.zeros((b, h, dk, dv), jnp.float32)
    _, o = lax.scan(step, state0, (to_chunks(q, c), to_chunks(k, c), to_chunks(v, c)))
    return from_chunks(o).astype(out_dtype)


def gated_linear_attention(q, k, v, log_a):
    out_dtype = v.dtype
    b, s, h, dk = q.shape
    dv = v.shape[-1]
    c = GLA_CHUNK
    q = q.astype(jnp.float32) * (dk ** -0.5)
    k = k.astype(jnp.float32)
    v = v.astype(jnp.float32)
    log_a = log_a.astype(jnp.float32)
    mask = jnp.tril(jnp.ones((c, c), dtype=bool))[:, :, None]

    def step(state, inp):
        qi, ki, vi, ai = inp
        bcum = jnp.cumsum(ai, axis=2)
        rel = bcum[:, :, :, None, :] - bcum[:, :, None, :, :]
        dec = jnp.exp(jnp.where(mask, rel, -jnp.inf))
        sc = jnp.sum(qi[:, :, :, None, :] * ki[:, :, None, :, :] * dec, axis=-1)
        o = jnp.einsum('bhts,bhsv->bhtv', sc, vi) + jnp.einsum('bhtd,bhdv->bhtv', qi * jnp.exp(bcum), state)
        b_last = bcum[:, :, -1:, :]
        state = jnp.exp(b_last[:, :, 0, :])[..., None] * state + jnp.einsum(
            'bhsd,bhsv->bhdv', ki * jnp.exp(b_last - bcum), vi)
        return state, o

    state0 = jnp.zeros((b, h, dk, dv), jnp.float32)
    _, o = lax.scan(step, state0, (to_chunks(q, c), to_chunks(k, c), to_chunks(v, c), to_chunks(log_a, c)))
    return from_chunks(o).astype(out_dtype)


def causal_block_attention(q, k, v):
    b, s, h, d = q.shape
    dv = v.shape[-1]
    nb = s // MLA_BLOCK
    scale = d ** -0.5
    qb = q.reshape(b, nb, MLA_BLOCK, h, d).transpose(1, 0, 3, 2, 4)
    kh = k.transpose(0, 2, 1, 3)
    vh = v.transpose(0, 2, 1, 3)
    kpos = jnp.arange(s)

    def one_block(args):
        i, qi = args
        sc = jnp.einsum('bhqd,bhkd->bhqk', qi, kh).astype(jnp.float32) * scale
        qpos = i * MLA_BLOCK + jnp.arange(MLA_BLOCK)
        sc = jnp.where(kpos[None, :] <= qpos[:, None], sc, -jnp.inf)
        p = jax.nn.softmax(sc, axis=-1).astype(vh.dtype)
        return jnp.einsum('bhqk,bhkv->bhqv', p, vh)

    o = lax.map(one_block, (jnp.arange(nb), qb))
    return o.transpose(1, 0, 3, 2, 4).reshape(b, s, h * dv)


def hybrid_mixer(h, cos, sin, w_in, ret_out_norm,
                 mla_q_norm, mla_w_uq, mla_kv_norm, mla_w_ukv,
                 mla_q_nope_norm, mla_q_rope_norm, mla_k_nope_norm, mla_k_rope_norm,
                 gla_w_gate_up, gla_gate_bias, gla_out_norm, w_out):
    b, s, _ = h.shape
    proj = h @ w_in
    points = []
    acc = 0
    for sz in IN_SPLITS[:-1]:
        acc += sz
        points.append(acc)
    (ret_q, ret_k, ret_v, ret_g, mla_cq, mla_ckv, mla_kr,
     gla_q, gla_k, gla_v, gla_a_low, gla_r) = jnp.split(proj, points, axis=-1)

    rq = apply_rope(ret_q.reshape(b, s, RET_HEADS, RET_DK), cos, sin)
    rk = apply_rope(ret_k.reshape(b, s, RET_HEADS, RET_DK), cos, sin)
    rv = ret_v.reshape(b, s, RET_HEADS, RET_DV)
    ry = retention(rq, rk, rv).reshape(b, s, RET_HEADS, RET_DV)
    ry = rms_norm(ry, ret_out_norm.reshape(RET_HEADS, RET_DV)).reshape(b, s, RET_HEADS * RET_DV)
    ret_out = jax.nn.silu(ret_g) * ry

    cq = rms_norm(mla_cq, mla_q_norm)
    qf = (cq @ mla_w_uq).reshape(b, s, MLA_HEADS, MLA_NOPE + MLA_ROPE)
    ckv = rms_norm(mla_ckv, mla_kv_norm)
    kv = (ckv @ mla_w_ukv).reshape(b, s, MLA_HEADS, MLA_NOPE + MLA_DV)
    q_nope = rms_norm(qf[..., :MLA_NOPE], mla_q_nope_norm)
    q_rope = apply_rope(rms_norm(qf[..., MLA_NOPE:], mla_q_rope_norm), cos, sin)
    k_nope = rms_norm(kv[..., :MLA_NOPE], mla_k_nope_norm)
    mv = kv[..., MLA_NOPE:]
    k_rope = apply_rope(rms_norm(mla_kr, mla_k_rope_norm).reshape(b, s, 1, MLA_ROPE), cos, sin)
    k_rope = jnp.broadcast_to(k_rope, (b, s, MLA_HEADS, MLA_ROPE))
    mq = jnp.concatenate([q_nope, q_rope], axis=-1)
    mk = jnp.concatenate([k_nope, k_rope], axis=-1)
    mla_out = causal_block_attention(mq, mk, mv)

    gq = gla_q.reshape(b, s, GLA_HEADS, GLA_DK)
    gk = gla_k.reshape(b, s, GLA_HEADS, GLA_DK)
    gv = gla_v.reshape(b, s, GLA_HEADS, GLA_DV)
    log_a = jax.nn.log_sigmoid((gla_a_low @ gla_w_gate_up + gla_gate_bias).astype(jnp.float32)) / GLA_TAU
    log_a = log_a.reshape(b, s, GLA_HEADS, GLA_DK)
    gy = gated_linear_attention(gq, gk, gv, log_a).reshape(b, s, GLA_HEADS, GLA_DV)
    gy = rms_norm(gy, gla_out_norm.reshape(GLA_HEADS, GLA_DV)).reshape(b, s, GLA_HEADS * GLA_DV)
    gla_out = jax.nn.silu(gla_r) * gy

    return jnp.concatenate([ret_out, mla_out, gla_out], axis=-1) @ w_out


def setup_inputs(seed: int = 0) -> dict:
    key = jax.random.key(seed)
    ks = iter(jax.random.split(key, 32))

    def dense(shape):
        return jax.random.normal(next(ks), shape, jnp.float32) * (shape[-2] ** -0.5)

    def gain(n):
        return 1.0 + 0.02 * jax.random.normal(next(ks), (DEPTH, n), jnp.float32)

    x = jax.random.normal(next(ks), (BATCH, SEQ, D_MODEL), jnp.float32)
    positions = jnp.broadcast_to(jnp.arange(SEQ, dtype=jnp.int32), (BATCH, SEQ))
    return {
        "x": x,
        "positions": positions,
        "ffn1_norm": gain(D_MODEL),
        "ffn1_w_gate_up": dense((DEPTH, D_MODEL, 2 * D_FF)),
        "ffn1_w_down": dense((DEPTH, D_FF, D_MODEL)),
        "mix_norm": gain(D_MODEL),
        "w_in": dense((DEPTH, D_MODEL, IN_COLS)),
        "ret_out_norm": gain(RET_HEADS * RET_DV),
        "mla_q_norm": gain(MLA_Q_RANK),
        "mla_w_uq": dense((DEPTH, MLA_Q_RANK, MLA_HEADS * (MLA_NOPE + MLA_ROPE))),
        "mla_kv_norm": gain(MLA_KV_RANK),
        "mla_w_ukv": dense((DEPTH, MLA_KV_RANK, MLA_HEADS * (MLA_NOPE + MLA_DV))),
        "mla_q_nope_norm": gain(MLA_NOPE),
        "mla_q_rope_norm": gain(MLA_ROPE),
        "mla_k_nope_norm": gain(MLA_NOPE),
        "mla_k_rope_norm": gain(MLA_ROPE),
        "gla_w_gate_up": dense((DEPTH, GLA_GATE_RANK, GLA_HEADS * GLA_DK)),
        "gla_gate_bias": 0.1 * jax.random.normal(next(ks), (DEPTH, GLA_HEADS * GLA_DK), jnp.float32),
        "gla_out_norm": gain(GLA_HEADS * GLA_DV),
        "w_out": dense((DEPTH, D_MIX, D_MODEL)),
        "ffn2_norm": gain(D_MODEL),
        "ffn2_w_gate_up": dense((DEPTH, D_MODEL, 2 * D_FF)),
        "ffn2_w_down": dense((DEPTH, D_FF, D_MODEL)),
    }


def reference(x, positions, ffn1_norm, ffn1_w_gate_up, ffn1_w_down, mix_norm, w_in, ret_out_norm,
              mla_q_norm, mla_w_uq, mla_kv_norm, mla_w_ukv,
              mla_q_nope_norm, mla_q_rope_norm, mla_k_nope_norm, mla_k_rope_norm,
              gla_w_gate_up, gla_gate_bias, gla_out_norm, w_out,
              ffn2_norm, ffn2_w_gate_up, ffn2_w_down):
    cos, sin = rope_tables(positions, HEAD_DIM)
    for l in range(DEPTH):
        x = x + 0.5 * swiglu(rms_norm(x, ffn1_norm[l]), ffn1_w_gate_up[l], ffn1_w_down[l])
        h = rms_norm(x, mix_norm[l])
        x = x + hybrid_mixer(h, cos, sin, w_in[l], ret_out_norm[l],
                             mla_q_norm[l], mla_w_uq[l], mla_kv_norm[l], mla_w_ukv[l],
                             mla_q_nope_norm[l], mla_q_rope_norm[l], mla_k_nope_norm[l], mla_k_rope_norm[l],
                             gla_w_gate_up[l], gla_gate_bias[l], gla_out_norm[l], w_out[l])
        x = x + 0.5 * swiglu(rms_norm(x, ffn2_norm[l]), ffn2_w_gate_up[l], ffn2_w_down[l])
    return x
```

```cpp
#include <hip/hip_runtime.h>
#include <hip/hip_cooperative_groups.h>
#include <hip/hip_bf16.h>
#include <cstdio>
#include <cstdint>
namespace cg = cooperative_groups;
namespace pg8 {
#define PG8_LAS __attribute__((address_space(3)))
typedef unsigned short bf16_t;
typedef short bf16x8 __attribute__((ext_vector_type(8)));
typedef float f32x4 __attribute__((ext_vector_type(4)));
typedef unsigned u32x4 __attribute__((ext_vector_type(4)));
constexpr int BM = 256, BK = 64, HALF = 128, HTB = HALF * BK * 2  , STAGE_BYTES = 8 * HTB, NXCD = 8, WGM = 8;

__host__ __device__ __forceinline__ int lds_byte(int r, int c) { const int st = (r >> 4) * 2 + (c >> 5), rr = r & 15, cc = c & 31, ob = rr * 64 + cc * 2; return st * 1024 + (ob ^ (((ob >> 9) & 1) << 5)); }
__host__ __device__ __forceinline__ void stage_rc(int b, int& R, int& C) { const int st = b / 1024, sb = b % 1024, swz = sb ^ (((sb >> 9) & 1) << 5); R = (st >> 1) * 16 + swz / 64; C = (st & 1) * 32 + (swz % 64) / 2; }
__host__ __device__ __forceinline__ int perm32(int rho) { const int n = rho >> 4, i = rho & 15; return 8 * (i >> 2) + 4 * n + (i & 3); }

struct Unit { int pm, pn; };
struct Gemm { const bf16_t* A; const bf16_t* Bt; int M, N, K; };

struct StaticOrder {
    int nM, nN, nwg, G, c;
    __host__ __device__ void init(int M, int N, int G_, int c_) { nM = M / BM; nN = N / BM; nwg = nM * nN; G = G_; c = c_; }
    __host__ __device__ bool next(int i, Unit& u) const {
        const long L = (long)i * G + c; if (L >= nwg) return false;
        int wgid = (int)L; { const int q = nwg / NXCD, r = nwg % NXCD, xcd = wgid % NXCD, off = wgid / NXCD; wgid = (xcd < r ? xcd * (q + 1) : r * (q + 1) + (xcd - r) * q) + off; }
        const int nig = WGM * nN, gid = wgid / nig, fm = gid * WGM, gsz = (nM - fm) < WGM ? (nM - fm) : WGM;
        u.pm = fm + ((wgid % nig) % gsz); u.pn = (wgid % nig) / gsz; return true;
    }
    __device__ __forceinline__ void a_ready(const Unit&) const {}
    __device__ __forceinline__ void done(const Unit&) const {}
};

__device__ __forceinline__ unsigned cvt_pk_bf16(float lo, float hi) { unsigned r; asm volatile("v_cvt_pk_bf16_f32 %0, %1, %2" : "=v"(r) : "v"(lo), "v"(hi)); return r; }
template <class Epi, class Sched, bool ALIGN_EPI = false, bool SP2 = false>
__device__ __forceinline__ void gemm_phase(PG8_LAS unsigned char* lds, const Gemm g, const Sched& S, const Epi& E) {
    int tid_l = threadIdx.x; asm volatile("" : "+v"(tid_l)); const int tid = tid_l, wid = __builtin_amdgcn_readfirstlane(tid >> 6), lane = tid & 63, wr = wid >> 2, wc = wid & 3, fr = lane & 15, fq = lane >> 4;
    const int K = g.K, nt = K / BK;
    unsigned voffA[2], voffB[2];
#pragma unroll
    for (int i = 0; i < 2; ++i) { int R, C; stage_rc(tid * 16 + i * 8192, R, C); const int Rb = Epi::PERM ? ((R & ~31) + perm32(R & 31)) : R;
        voffA[i] = (unsigned)(R * K + C) * 2u; voffB[i] = (unsigned)(Rb * K + C) * 2u; }
    const size_t kstep = (size_t)(BK * 2);
    const size_t hstep = (size_t)HALF * K * 2;
    const size_t tstep = 2 * hstep;
    const unsigned ldsw = (unsigned)wid * 1024u;
    const int aoff = lds_byte(wr * 64 + fr, fq * 8), boff = lds_byte(wc * 32 + fr, fq * 8);
#define PG8_SA(b, h) (((b) * 2 + (h)) * HTB)
#define PG8_SB(b, h) ((4 + (b) * 2 + (h)) * HTB)
#define PG8_STAGE(bufoff, gbase, voff) do { _Pragma("unroll") for (int _i = 0; _i < 2; ++_i) \
        __builtin_amdgcn_global_load_lds((const unsigned*)((const char*)(gbase) + (voff)[_i]), (PG8_LAS unsigned*)(lds + (bufoff) + ldsw + _i * 8192), 16, 0, 0); } while (0)
#define PG8_LDA(dst, b, h) do { _Pragma("unroll") for (int m = 0; m < 4; ++m) _Pragma("unroll") for (int k = 0; k < 2; ++k) dst[m][k] = *(const PG8_LAS bf16x8*)(lds + PG8_SA(b, h) + aoff + m * 2048 + k * 1024); } while (0)
#define PG8_LDB(dst, b, h) do { _Pragma("unroll") for (int n = 0; n < 2; ++n) _Pragma("unroll") for (int k = 0; k < 2; ++k) dst[n][k] = *(const PG8_LAS bf16x8*)(lds + PG8_SB(b, h) + boff + n * 2048 + k * 1024); } while (0)
#define PG8_MMA(ai, bj, At, Bt) do { __builtin_amdgcn_s_setprio(1); _Pragma("unroll") for (int m = 0; m < 4; ++m) _Pragma("unroll") for (int n = 0; n < 2; ++n) _Pragma("unroll") for (int k = 0; k < 2; ++k) \
        acc[ai][bj][m][n] = __builtin_amdgcn_mfma_f32_16x16x32_bf16(Bt[n][k], At[m][k], acc[ai][bj][m][n], 0, 0, 0); __builtin_amdgcn_s_setprio(0); } while (0)
#define PG8_WAIT_V(n) asm volatile("s_waitcnt vmcnt(" #n ")" ::: "memory")
#define PG8_WAIT_L(n) asm volatile("s_waitcnt lgkmcnt(" #n ")" ::: "memory")
#define PG8_BAR __builtin_amdgcn_s_barrier()
#define PG8_SCHED __builtin_amdgcn_sched_barrier(0)
    Unit cur, nxt; int ui = 0;
    if (!S.next(0, cur)) return;
    f32x4 acc[2][2][4][2];
#pragma unroll
    for (int a = 0; a < 2; ++a)
#pragma unroll
        for (int b = 0; b < 2; ++b)
#pragma unroll
            for (int m = 0; m < 4; ++m)
#pragma unroll
                for (int n = 0; n < 2; ++n) acc[a][b][m][n] = (f32x4){0.f, 0.f, 0.f, 0.f};
    bf16x8 At[4][2], B0[2][2], B1[2][2];
    const char* cA = (const char*)g.A + (size_t)cur.pm * tstep; const char* cB = (const char*)g.Bt + (size_t)cur.pn * tstep;
    S.a_ready(cur);
    if constexpr (SP2) {
        PG8_STAGE(PG8_SB(0, 0), cB, voffB); PG8_STAGE(PG8_SB(0, 1), cB + hstep, voffB); PG8_STAGE(PG8_SA(0, 0), cA, voffA); PG8_STAGE(PG8_SA(0, 1), cA + hstep, voffA);
        if (wr == 1) PG8_BAR;
        PG8_WAIT_V(2); PG8_BAR;
        PG8_STAGE(PG8_SB(1, 0), cB + kstep, voffB); PG8_STAGE(PG8_SA(1, 0), cA + kstep, voffA); PG8_STAGE(PG8_SB(1, 1), cB + hstep + kstep, voffB);
        PG8_WAIT_V(6); PG8_BAR;
    } else {
        PG8_STAGE(PG8_SB(0, 0), cB, voffB); PG8_STAGE(PG8_SA(0, 0), cA, voffA); PG8_STAGE(PG8_SB(0, 1), cB + hstep, voffB); PG8_STAGE(PG8_SA(0, 1), cA + hstep, voffA);
        if (wr == 1) PG8_BAR;
        PG8_WAIT_V(4); PG8_BAR;
        PG8_STAGE(PG8_SB(1, 0), cB + kstep, voffB); PG8_STAGE(PG8_SA(1, 0), cA + kstep, voffA); PG8_STAGE(PG8_SB(1, 1), cB + hstep + kstep, voffB);
        PG8_WAIT_V(6); PG8_BAR;
    }
    for (;;) {
        const bool has_next = S.next(ui + 1, nxt);
        const char* nA = has_next ? (const char*)g.A + (size_t)nxt.pm * tstep : cA; const char* nB = has_next ? (const char*)g.Bt + (size_t)nxt.pn * tstep : cB;
        for (int t = 0; t < nt; t += 2) {
            const bool last = (t == nt - 2);
            const char* a1 = cA + (size_t)(t + 1) * kstep;
            const char* a2 = last ? nA : cA + (size_t)(t + 2) * kstep; const char* b2 = last ? nB : cB + (size_t)(t + 2) * kstep;
            const char* a3 = a2 + kstep; const char* b3 = b2 + kstep;
            if (last && has_next) S.a_ready(nxt);
            if constexpr (SP2) {
            PG8_LDB(B0, 0, 0); PG8_LDB(B1, 0, 1); PG8_SCHED; PG8_LDA(At, 0, 0); PG8_STAGE(PG8_SA(1, 1), a1 + hstep, voffA);
            PG8_WAIT_V(8); PG8_WAIT_L(0); PG8_BAR; PG8_MMA(0, 0, At, B0); PG8_MMA(0, 1, At, B1); PG8_BAR; PG8_SCHED;
            PG8_LDA(At, 0, 1); PG8_STAGE(PG8_SB(0, 0), b2, voffB); PG8_STAGE(PG8_SB(0, 1), b2 + hstep, voffB); PG8_STAGE(PG8_SA(0, 0), a2, voffA);
            PG8_WAIT_V(8); PG8_WAIT_L(0); PG8_BAR; PG8_MMA(1, 0, At, B0); PG8_MMA(1, 1, At, B1); PG8_BAR; PG8_SCHED;
            PG8_LDB(B0, 1, 0); PG8_LDB(B1, 1, 1); PG8_SCHED; PG8_LDA(At, 1, 0); PG8_STAGE(PG8_SA(0, 1), a2 + hstep, voffA);
            PG8_WAIT_V(8); PG8_WAIT_L(0); PG8_BAR; PG8_MMA(0, 0, At, B0); PG8_MMA(0, 1, At, B1); PG8_BAR; PG8_SCHED;
            PG8_LDA(At, 1, 1); PG8_STAGE(PG8_SB(1, 0), b3, voffB); PG8_STAGE(PG8_SB(1, 1), b3 + hstep, voffB); PG8_STAGE(PG8_SA(1, 0), a3, voffA);
            PG8_WAIT_V(8); PG8_WAIT_L(0); PG8_BAR; PG8_MMA(1, 0, At, B0); PG8_MMA(1, 1, At, B1); PG8_BAR; PG8_SCHED;
            } else {
            PG8_LDB(B0, 0, 0); PG8_SCHED; PG8_LDA(At, 0, 0); PG8_STAGE(PG8_SA(1, 1), a1 + hstep, voffA);
            PG8_WAIT_L(8); PG8_BAR; PG8_WAIT_L(0); PG8_MMA(0, 0, At, B0); PG8_BAR; PG8_SCHED;
            PG8_LDB(B1, 0, 1); PG8_STAGE(PG8_SB(0, 0), b2, voffB);
            PG8_BAR; PG8_WAIT_L(0); PG8_MMA(0, 1, At, B1); PG8_BAR;
            PG8_LDA(At, 0, 1); PG8_STAGE(PG8_SA(0, 0), a2, voffA);
            PG8_BAR; PG8_WAIT_L(0); PG8_MMA(1, 0, At, B0); PG8_BAR; PG8_SCHED;
            PG8_STAGE(PG8_SB(0, 1), b2 + hstep, voffB);
            PG8_WAIT_V(6); PG8_BAR; PG8_MMA(1, 1, At, B1); PG8_BAR;
            PG8_LDB(B0, 1, 0); PG8_SCHED; PG8_LDA(At, 1, 0); PG8_STAGE(PG8_SA(0, 1), a2 + hstep, voffA);
            PG8_WAIT_L(8); PG8_BAR; PG8_WAIT_L(0); PG8_MMA(0, 0, At, B0); PG8_BAR; PG8_SCHED;
            PG8_LDB(B1, 1, 1); PG8_STAGE(PG8_SB(1, 0), b3, voffB);
            PG8_BAR; PG8_WAIT_L(0); PG8_MMA(0, 1, At, B1); PG8_BAR;
            PG8_LDA(At, 1, 1); PG8_STAGE(PG8_SA(1, 0), a3, voffA);
            PG8_BAR; PG8_WAIT_L(0); PG8_MMA(1, 0, At, B0); PG8_BAR; PG8_SCHED;
            PG8_STAGE(PG8_SB(1, 1), b3 + hstep, voffB);
            PG8_WAIT_V(6); PG8_BAR; PG8_MMA(1, 1, At, B1); PG8_BAR;
            }
        }
        if constexpr (ALIGN_EPI) { if (wr == 0) PG8_BAR; }
        if constexpr (!Epi::AFTER_DRAIN) { E(acc, cur, wr, wc, fr, fq); S.done(cur); }
        if (!has_next) break;
#pragma unroll
        for (int a = 0; a < 2; ++a)
#pragma unroll
            for (int b = 0; b < 2; ++b)
#pragma unroll
                for (int m = 0; m < 4; ++m)
#pragma unroll
                    for (int n = 0; n < 2; ++n) acc[a][b][m][n] = (f32x4){0.f, 0.f, 0.f, 0.f};
        cur = nxt; cA = nA; cB = nB; ++ui;
        if constexpr (ALIGN_EPI) { if (wr == 1) PG8_BAR; }
    }
    PG8_WAIT_V(0);
    if constexpr (!ALIGN_EPI) { if (wr == 0) PG8_BAR; }
    PG8_BAR;
    if constexpr (Epi::AFTER_DRAIN) { E.fused(acc, cur, wr, wc, fr, fq, lds, wid, lane); S.done(cur); }
#undef PG8_SA
#undef PG8_SB
#undef PG8_STAGE
#undef PG8_LDA
#undef PG8_LDB
#undef PG8_MMA
#undef PG8_WAIT_V
#undef PG8_WAIT_L
#undef PG8_BAR
#undef PG8_SCHED
}
}
namespace pg8 {
__device__ __forceinline__ void load_rstd(const float* ssq, const Unit& u, int wr, int fr, int fq, float (&rs)[2][4]) {
#pragma unroll
    for (int ai = 0; ai < 2; ++ai)
#pragma unroll
        for (int m = 0; m < 4; ++m) {
            const int row = u.pm * BM + ai * HALF + wr * 64 + m * 16 + fr;
            const f32x4 v = *(const f32x4*)(ssq + (size_t)row * 16 + 4 * fq);
            float s = (v[0] + v[1]) + (v[2] + v[3]);
            s += __shfl_xor(s, 16); s += __shfl_xor(s, 32);
            rs[ai][m] = rsqrtf(s * (1.0f / 1024.0f) + 1e-6f);
        }
}
__device__ __forceinline__ float silu_f(float g) { return g * __builtin_amdgcn_rcpf(1.0f + __expf(-g)); }
struct EpiSwiGLU {
    static constexpr bool PERM = true, AFTER_DRAIN = false;
    bf16_t* O; const float* ssq; int ldo;
    __device__ __forceinline__ void operator()(const f32x4 (&acc)[2][2][4][2], const Unit& u, int wr, int wc, int fr, int fq) const {
        float rs[2][4]; load_rstd(ssq, u, wr, fr, fq, rs);
        const int col0 = u.pn * 128 + wc * 32 + 8 * fq;
#pragma unroll
        for (int ai = 0; ai < 2; ++ai)
#pragma unroll
            for (int m = 0; m < 4; ++m) {
                const int row = u.pm * BM + ai * HALF + wr * 64 + m * 16 + fr; const float r = rs[ai][m];
                u32x4 w;
#pragma unroll
                for (int n = 0; n < 2; ++n) {
                    const f32x4 g = acc[ai][0][m][n] * r, uu = acc[ai][1][m][n] * r;
                    const float h0 = silu_f(g[0]) * uu[0], h1 = silu_f(g[1]) * uu[1], h2 = silu_f(g[2]) * uu[2], h3 = silu_f(g[3]) * uu[3];
                    w[2 * n] = cvt_pk_bf16(h0, h1); w[2 * n + 1] = cvt_pk_bf16(h2, h3);
                }
                *(u32x4*)(O + (size_t)row * ldo + col0) = w;
            }
    }
};
struct EpiResid {
    static constexpr bool PERM = true, AFTER_DRAIN = false;
    float* out_final; bf16_t* xb; float* ssq; float alpha;
    __device__ __forceinline__ void operator()(const f32x4 (&acc)[2][2][4][2], const Unit& u, int wr, int wc, int fr, int fq) const {
        const int col0 = u.pn * BM + wc * 32 + 8 * fq;
#pragma unroll
        for (int ai = 0; ai < 2; ++ai)
#pragma unroll
            for (int m = 0; m < 4; ++m) {
                const int row = u.pm * BM + ai * HALF + wr * 64 + m * 16 + fr; float ss = 0.f;
#pragma unroll
                for (int bj = 0; bj < 2; ++bj) {
                    const size_t off = (size_t)row * 1024 + col0 + bj * HALF;
                    const u32x4 xo = *(const u32x4*)(xb + off);
                    f32x4 x0, x1;
                    x0[0] = __builtin_bit_cast(float, xo[0] << 16); x0[1] = __builtin_bit_cast(float, xo[0] & 0xffff0000u); x0[2] = __builtin_bit_cast(float, xo[1] << 16); x0[3] = __builtin_bit_cast(float, xo[1] & 0xffff0000u);
                    x1[0] = __builtin_bit_cast(float, xo[2] << 16); x1[1] = __builtin_bit_cast(float, xo[2] & 0xffff0000u); x1[2] = __builtin_bit_cast(float, xo[3] << 16); x1[3] = __builtin_bit_cast(float, xo[3] & 0xffff0000u);
                    x0 += acc[ai][bj][m][0] * alpha; x1 += acc[ai][bj][m][1] * alpha;
                    if (out_final) { *(f32x4*)(out_final + off) = x0; *(f32x4*)(out_final + off + 4) = x1; }
                    else {
                        u32x4 w; w[0] = cvt_pk_bf16(x0[0], x0[1]); w[1] = cvt_pk_bf16(x0[2], x0[3]); w[2] = cvt_pk_bf16(x1[0], x1[1]); w[3] = cvt_pk_bf16(x1[2], x1[3]);
                        *(u32x4*)(xb + off) = w;
                        ss += (x0[0] * x0[0] + x0[1] * x0[1]) + (x0[2] * x0[2] + x0[3] * x0[3]) + (x1[0] * x1[0] + x1[1] * x1[1]) + (x1[2] * x1[2] + x1[3] * x1[3]);
                    }
                }
                if (!out_final) { ss += __shfl_xor(ss, 16); ss += __shfl_xor(ss, 32);
                    if (fq == 0) ssq[(size_t)row * 16 + u.pn * 4 + wc] = ss; }
            }
    }
};
struct EpiPlain {
    static constexpr bool PERM = true, AFTER_DRAIN = false;
    bf16_t* O; int ldo; int col_off; const float* ssq;
    const float* kn_gain; PG8_LAS float* red;
    __device__ __forceinline__ void operator()(const f32x4 (&acc)[2][2][4][2], const Unit& u, int wr, int wc, int fr, int fq) const {
        float rs[2][4];
        if (ssq) load_rstd(ssq, u, wr, fr, fq, rs);
        if (kn_gain) {
#pragma unroll
            for (int ai = 0; ai < 2; ++ai)
#pragma unroll
                for (int m = 0; m < 4; ++m) { const f32x4 a = acc[ai][0][m][0], b = acc[ai][0][m][1];
                    float ss = (a[0] * a[0] + a[1] * a[1]) + (a[2] * a[2] + a[3] * a[3]) + (b[0] * b[0] + b[1] * b[1]) + (b[2] * b[2] + b[3] * b[3]);
                    ss += __shfl_xor(ss, 16); ss += __shfl_xor(ss, 32);
                    if (fq == 0) red[(ai * HALF + wr * 64 + m * 16 + fr) * 4 + wc] = ss; }
            asm volatile("s_waitcnt lgkmcnt(0)\n\ts_barrier" ::: "memory");
#pragma unroll
            for (int ai = 0; ai < 2; ++ai)
#pragma unroll
                for (int m = 0; m < 4; ++m) { const f32x4 p = *(const PG8_LAS f32x4*)(red + (ai * HALF + wr * 64 + m * 16 + fr) * 4);
                    rs[ai][m] = rsqrtf(((p[0] + p[1]) + (p[2] + p[3])) * (1.0f / 128.0f) + 1e-6f); }
        }
        const int col0 = col_off + u.pn * BM + wc * 32 + 8 * fq;
#pragma unroll
        for (int ai = 0; ai < 2; ++ai)
#pragma unroll
            for (int m = 0; m < 4; ++m) {
                const int row = u.pm * BM + ai * HALF + wr * 64 + m * 16 + fr; const float r = (ssq || kn_gain) ? rs[ai][m] : 1.0f;
#pragma unroll
                for (int bj = 0; bj < 2; ++bj) {
                    f32x4 v0 = acc[ai][bj][m][0], v1 = acc[ai][bj][m][1];
                    if (!kn_gain || bj == 0) { v0 = v0 * r; v1 = v1 * r; }
                    u32x4 w; w[0] = cvt_pk_bf16(v0[0], v0[1]); w[1] = cvt_pk_bf16(v0[2], v0[3]); w[2] = cvt_pk_bf16(v1[0], v1[1]); w[3] = cvt_pk_bf16(v1[2], v1[3]);
                    *(u32x4*)(O + (size_t)row * ldo + col0 + bj * HALF) = w;
                }
            }
    }
};
}
namespace att {
typedef unsigned short bf16_t;
typedef short bf16x8 __attribute__((ext_vector_type(8)));
typedef short s16x4 __attribute__((ext_vector_type(4)));
typedef float f32x16 __attribute__((ext_vector_type(16)));
typedef float f32x4 __attribute__((ext_vector_type(4)));
typedef unsigned u32x4 __attribute__((ext_vector_type(4)));
constexpr int DQK = 192, DV = 128, SEQ = 16384;
constexpr int LDQ = 768, LDK = 1024, LDKR = 64, LDV = 1024, LDO = 1024;
constexpr float SCALE = 0.07216878364870322f;
constexpr float THR = 8.f;
constexpr int NW = 8, QBLK = 32, KVBLK = 64, QB = NW * QBLK;
constexpr int SHM_V = KVBLK * DV * 2, SHM_K = KVBLK * DQK * 2;
constexpr int LDS_BYTES = 2 * SHM_V + 2 * SHM_K + NW * 64 * 4;
#define KSWZ(row, colB) ((row) * 384 + ((colB) ^ ((((row) >> 1) & 7) << 4)))
#define SBAR() __builtin_amdgcn_sched_barrier(0)
__device__ __forceinline__ int v_st(int k, int c) { const int kk = (k & ~0xC) | ((k & 4) << 1) | ((k & 8) >> 1); return ((kk >> 3) * 4 + (c >> 5)) * 512 + ((kk & 7) * 32 + (c & 31)) * 2; }
__device__ __forceinline__ int v_rd_base(int lane) { return ((lane & 3) << 3) | (((lane >> 2) & 3) << 6) | (((lane >> 4) & 1) << 5) | (((lane >> 5) & 1) << 8); }
constexpr int v_rd_off(int d0, int ks, int half) { return d0 * 512 + ks * 4096 + half * 2048; }
__device__ __forceinline__ int crow(int r, int hi) { return (r & 3) + 8 * (r >> 2) + 4 * hi; }
__device__ __forceinline__ unsigned cvtpk(float lo, float hi) { unsigned r; asm volatile("v_cvt_pk_bf16_f32 %0, %1, %2" : "=v"(r) : "v"(lo), "v"(hi)); return r; }
__device__ __forceinline__ bf16x8 load8(const bf16_t* p) { return *reinterpret_cast<const bf16x8*>(p); }
__device__ __forceinline__ void mask_tile(f32x16& p0, f32x16& p1, int dq) {
    const float NEG = -__builtin_inff();
#pragma unroll
    for (int r = 0; r < 16; ++r) {
        const int c = (r & 3) + 8 * (r >> 2);
        if (dq - c < 0) p0[r] = NEG;
        if (dq - c - 32 < 0) p1[r] = NEG;
    }
}
__device__ __forceinline__ void partialSM(f32x16& p0, f32x16& p1, float& m_reg, float& mn, float& alpha) {
    float pmax = p0[0];
#pragma unroll
    for (int r = 1; r < 16; ++r) pmax = fmaxf(pmax, p0[r]);
#pragma unroll
    for (int r = 0; r < 16; ++r) pmax = fmaxf(pmax, p1[r]);
    { auto rr = __builtin_amdgcn_permlane32_swap(__float_as_uint(pmax), __float_as_uint(pmax), false, false);
      pmax = fmaxf(__uint_as_float(rr[0]), __uint_as_float(rr[1])); }
    constexpr float C2 = 1.4426950408889634f * SCALE;
    if (__builtin_expect(__all((pmax - m_reg) * SCALE <= THR), 1)) { mn = m_reg; alpha = 1.f; }
    else { mn = fmaxf(m_reg, pmax); alpha = __builtin_amdgcn_exp2f((m_reg - mn) * C2); m_reg = mn; }
    const float mnL = -mn * C2;
#pragma unroll
    for (int r = 0; r < 16; ++r) p0[r] = fmaf(p0[r], C2, mnL);
#pragma unroll
    for (int r = 0; r < 16; ++r) p1[r] = fmaf(p1[r], C2, mnL);
#pragma unroll
    for (int r = 0; r < 16; ++r) p0[r] = __builtin_amdgcn_exp2f(p0[r]);
}
__device__ __forceinline__ void finishSM(f32x16& p0, f32x16& p1, float alpha, float& l_reg, bf16x8& pa0, bf16x8& pa1, bf16x8& pa2, bf16x8& pa3) {
#pragma unroll
    for (int r = 0; r < 16; ++r) p1[r] = __builtin_amdgcn_exp2f(p1[r]);
    float ps = 0;
#pragma unroll
    for (int r = 0; r < 16; ++r) ps += p0[r];
#pragma unroll
    for (int r = 0; r < 16; ++r) ps += p1[r];
    { auto rr = __builtin_amdgcn_permlane32_swap(__float_as_uint(ps), __float_as_uint(ps), false, false);
      ps = __uint_as_float(rr[0]) + __uint_as_float(rr[1]); }
    l_reg = l_reg * alpha + ps;
#define PK4(P, B_, OUT) do { unsigned a0 = cvtpk(P[B_+0], P[B_+1]), a1 = cvtpk(P[B_+2], P[B_+3]);                          \
        unsigned b0 = cvtpk(P[B_+4], P[B_+5]), b1 = cvtpk(P[B_+6], P[B_+7]);                                             \
        auto r0 = __builtin_amdgcn_permlane32_swap(a0, b0, false, false); auto r1 = __builtin_amdgcn_permlane32_swap(a1, b1, false, false); \
        u32x4 w = {r0[0], r1[0], r0[1], r1[1]}; OUT = *reinterpret_cast<bf16x8*>(&w); } while (0)
    PK4(p0, 0, pa0); PK4(p0, 8, pa1); PK4(p1, 0, pa2); PK4(p1, 8, pa3);
#undef PK4
}
__device__ __forceinline__ void staticSM(f32x16& p0, f32x16& p1, float mB) {
    constexpr float C2 = 1.4426950408889634f * SCALE;
#pragma unroll
    for (int r = 0; r < 16; ++r) p0[r] = __builtin_amdgcn_exp2f(fmaf(p0[r], C2, -mB));
}
template <int KB>
__device__ __forceinline__ void qkt(f32x16& p0, f32x16& p1, const char* K_lds, int r32, int hi, const bf16x8* qr) {
    p0 = f32x16{}; p1 = f32x16{};
    const char* kb[4];
#pragma unroll
    for (int dd = 0; dd < 4; ++dd) kb[dd] = K_lds + KB * SHM_K + KSWZ(r32, (dd * 16 + hi * 8) * 2);
    bf16x8 fa[3], fb[3];
#pragma unroll
    for (int d0 = 0; d0 < 2; ++d0) { const char* a = kb[d0 & 3] + (d0 >> 2) * 128; fa[d0] = *reinterpret_cast<const bf16x8*>(a); fb[d0] = *reinterpret_cast<const bf16x8*>(a + 32 * 384); }
    __builtin_amdgcn_sched_barrier(0);
#pragma unroll
    for (int d0 = 0; d0 < 12; ++d0) {
        if (d0 + 2 < 12) { const char* a = kb[(d0 + 2) & 3] + ((d0 + 2) >> 2) * 128; fa[(d0 + 2) % 3] = *reinterpret_cast<const bf16x8*>(a); fb[(d0 + 2) % 3] = *reinterpret_cast<const bf16x8*>(a + 32 * 384); }
        p0 = __builtin_amdgcn_mfma_f32_32x32x16_bf16(fa[d0 % 3], qr[d0], p0, 0, 0, 0);
        p1 = __builtin_amdgcn_mfma_f32_32x32x16_bf16(fb[d0 % 3], qr[d0], p1, 0, 0, 0);
        __builtin_amdgcn_sched_barrier(0);
    }
}
template <int VB>
__device__ __forceinline__ void pv_tile(f32x16* o, int vb0, bf16x8 pa0, bf16x8 pa1, bf16x8 pa2, bf16x8 pa3) {
#define TRRD(dst, off) asm volatile("ds_read_b64_tr_b16 %0, %1 offset:%2" : "=&v"(dst) : "v"(vb0), "i"(off) : "memory")
#define PV_D0(d0) do { s16x4 l0, l1, l2, l3, h0, h1, h2, h3; constexpr int b_ = VB * SHM_V + v_rd_off(d0, 0, 0);    \
        TRRD(l0, b_); TRRD(h0, b_ + 2048); TRRD(l1, b_ + 4096); TRRD(h1, b_ + 6144); TRRD(l2, b_ + 8192); TRRD(h2, b_ + 10240); TRRD(l3, b_ + 12288); TRRD(h3, b_ + 14336); \
        asm volatile("s_waitcnt lgkmcnt(0)" ::: "memory"); SBAR();                                                   \
        o[d0] = __builtin_amdgcn_mfma_f32_32x32x16_bf16(pa0, (bf16x8){l0[0], l0[1], l0[2], l0[3], h0[0], h0[1], h0[2], h0[3]}, o[d0], 0, 0, 0);   \
        o[d0] = __builtin_amdgcn_mfma_f32_32x32x16_bf16(pa1, (bf16x8){l1[0], l1[1], l1[2], l1[3], h1[0], h1[1], h1[2], h1[3]}, o[d0], 0, 0, 0);   \
        o[d0] = __builtin_amdgcn_mfma_f32_32x32x16_bf16(pa2, (bf16x8){l2[0], l2[1], l2[2], l2[3], h2[0], h2[1], h2[2], h2[3]}, o[d0], 0, 0, 0);   \
        o[d0] = __builtin_amdgcn_mfma_f32_32x32x16_bf16(pa3, (bf16x8){l3[0], l3[1], l3[2], l3[3], h3[0], h3[1], h3[2], h3[3]}, o[d0], 0, 0, 0); } while (0)
    PV_D0(0); PV_D0(1); PV_D0(2); PV_D0(3);
#undef PV_D0
#undef TRRD
}
template <int VB>
__device__ __forceinline__ void pv_tile_pipe(f32x16* o, int vb0, bf16x8 pa0, bf16x8 pa1, bf16x8 pa2, bf16x8 pa3) {
#define TRRD(dst, off) asm volatile("ds_read_b64_tr_b16 %0, %1 offset:%2" : "=&v"(dst) : "v"(vb0), "i"(off) : "memory")
#define PV_RD(S, d0) do { constexpr int b_ = VB * SHM_V + v_rd_off(d0, 0, 0); TRRD(S[0], b_); TRRD(S[1], b_ + 2048); TRRD(S[2], b_ + 4096); TRRD(S[3], b_ + 6144); TRRD(S[4], b_ + 8192); TRRD(S[5], b_ + 10240); TRRD(S[6], b_ + 12288); TRRD(S[7], b_ + 14336); } while (0)
#define PV_MM(S, d0) do {                                                                                                                   \
        o[d0] = __builtin_amdgcn_mfma_f32_32x32x16_bf16(pa0, (bf16x8){S[0][0], S[0][1], S[0][2], S[0][3], S[1][0], S[1][1], S[1][2], S[1][3]}, o[d0], 0, 0, 0);   \
        o[d0] = __builtin_amdgcn_mfma_f32_32x32x16_bf16(pa1, (bf16x8){S[2][0], S[2][1], S[2][2], S[2][3], S[3][0], S[3][1], S[3][2], S[3][3]}, o[d0], 0, 0, 0);   \
        o[d0] = __builtin_amdgcn_mfma_f32_32x32x16_bf16(pa2, (bf16x8){S[4][0], S[4][1], S[4][2], S[4][3], S[5][0], S[5][1], S[5][2], S[5][3]}, o[d0], 0, 0, 0);   \
        o[d0] = __builtin_amdgcn_mfma_f32_32x32x16_bf16(pa3, (bf16x8){S[6][0], S[6][1], S[6][2], S[6][3], S[7][0], S[7][1], S[7][2], S[7][3]}, o[d0], 0, 0, 0); } while (0)
    s16x4 A[8], B[8];
    PV_RD(A, 0); asm volatile("s_waitcnt lgkmcnt(0)" ::: "memory"); SBAR();
    PV_RD(B, 1); SBAR(); PV_MM(A, 0); asm volatile("s_waitcnt lgkmcnt(0)" ::: "memory"); SBAR();
    PV_RD(A, 2); SBAR(); PV_MM(B, 1); asm volatile("s_waitcnt lgkmcnt(0)" ::: "memory"); SBAR();
    PV_RD(B, 3); SBAR(); PV_MM(A, 2); asm volatile("s_waitcnt lgkmcnt(0)" ::: "memory"); SBAR();
    PV_MM(B, 3);
#undef PV_RD
#undef PV_MM
#undef TRRD
}
struct QNorm { const float* gqn; const float* gkn; const float* gqr; const float* rc; const float* rsn; };
__device__ __forceinline__ float bfbits2f(short v) { return __builtin_bit_cast(float, (unsigned)(unsigned short)v << 16); }
__device__ __forceinline__ short f2bfbits(float f) { unsigned u = __builtin_bit_cast(unsigned, f); return (short)((u + 0x7fffu + ((u >> 16) & 1u)) >> 16); }
__device__ __forceinline__ void q_postproc(bf16x8* qr, const QNorm& qn, int tok, int hi) {
    float s1 = 0.f, s2 = 0.f;
#pragma unroll
    for (int d0 = 0; d0 < 12; ++d0)
#pragma unroll
        for (int j = 0; j < 8; ++j) { const float v = bfbits2f(qr[d0][j]); if (d0 < 8) s1 += v * v; else s2 += v * v; }
    { auto rr = __builtin_amdgcn_permlane32_swap(__float_as_uint(s1), __float_as_uint(s1), false, false); s1 = __uint_as_float(rr[0]) + __uint_as_float(rr[1]); }
    { auto rr = __builtin_amdgcn_permlane32_swap(__float_as_uint(s2), __float_as_uint(s2), false, false); s2 = __uint_as_float(rr[0]) + __uint_as_float(rr[1]); }
    const float r1 = rsqrtf(s1 * (1.0f / 128.0f) + 1e-6f), r2 = rsqrtf(s2 * (1.0f / 64.0f) + 1e-6f);
#pragma unroll
    for (int d0 = 0; d0 < 8; ++d0) { const f32x4 g0 = *(const f32x4*)(qn.gqn + 16 * d0 + 8 * hi) * *(const f32x4*)(qn.gkn + 16 * d0 + 8 * hi), g1 = *(const f32x4*)(qn.gqn + 16 * d0 + 8 * hi + 4) * *(const f32x4*)(qn.gkn + 16 * d0 + 8 * hi + 4);
#pragma unroll
        for (int j = 0; j < 8; ++j) qr[d0][j] = f2bfbits(bfbits2f(qr[d0][j]) * r1 * (j < 4 ? g0[j] : g1[j - 4]));
        if (d0 & 1) asm volatile("" ::: "memory"); }
#pragma unroll
    for (int d0 = 8; d0 < 10; ++d0) { const int i0 = 16 * (d0 - 8) + 8 * hi;
        const f32x4 ga0 = *(const f32x4*)(qn.gqr + i0), ga1 = *(const f32x4*)(qn.gqr + i0 + 4), gb0 = *(const f32x4*)(qn.gqr + 32 + i0), gb1 = *(const f32x4*)(qn.gqr + 32 + i0 + 4);
        const f32x4 c0 = *(const f32x4*)(qn.rc + (size_t)tok * 32 + i0), c1 = *(const f32x4*)(qn.rc + (size_t)tok * 32 + i0 + 4), n0 = *(const f32x4*)(qn.rsn + (size_t)tok * 32 + i0), n1 = *(const f32x4*)(qn.rsn + (size_t)tok * 32 + i0 + 4);
#pragma unroll
        for (int j = 0; j < 8; ++j) { const float x1 = bfbits2f(qr[d0][j]) * r2 * (j < 4 ? ga0[j] : ga1[j - 4]), x2 = bfbits2f(qr[d0 + 2][j]) * r2 * (j < 4 ? gb0[j] : gb1[j - 4]);
            const float c = j < 4 ? c0[j] : c1[j - 4], sn = j < 4 ? n0[j] : n1[j - 4];
            qr[d0][j] = f2bfbits(x1 * c - x2 * sn); qr[d0 + 2][j] = f2bfbits(x1 * sn + x2 * c); } }
}
struct BlockRef { const bf16_t* Q; const bf16_t* K; const bf16_t* KR; bf16_t* O; int P0; int tok0; };
#define VMW() asm volatile("s_waitcnt vmcnt(0)" ::: "memory")
struct StReg { bf16x8 v0, v1, k0, k1, k2; };
#define SLOAD_H(S_, k0_) do { S_.v0 = load8(Vh + (size_t)((k0_) + sr) * LDV + sc); S_.v1 = load8(Vh + (size_t)((k0_) + 32 + sr) * LDV + sc);   \
        S_.k0 = load8(Kh + (size_t)((k0_) + kr0) * LDK + kc0); S_.k1 = load8(Kh + (size_t)((k0_) + kr1) * LDK + kc1); S_.k2 = load8(KRh + (size_t)((k0_) + kr2) * LDKR + (kc2 - 128)); } while (0)
#define SWRITE_H(S_, bf) do { *(bf16x8*)(V_lds + (bf) * SHM_V + vst0) = S_.v0; *(bf16x8*)(V_lds + (bf) * SHM_V + vst1) = S_.v1;            \
        *(bf16x8*)(K_lds + (bf) * SHM_K + kws0) = S_.k0; *(bf16x8*)(K_lds + (bf) * SHM_K + kws1) = S_.k1; *(bf16x8*)(K_lds + (bf) * SHM_K + kws2) = S_.k2; } while (0)
template <bool STATIC>
__device__ __forceinline__ void attn_block(const BlockRef& cur, char* lds, float mB, const QNorm& qn) {
    int tid_l = threadIdx.x; asm volatile("" : "+v"(tid_l)); const int tid = tid_l, wid = __builtin_amdgcn_readfirstlane(tid >> 6), lane = tid & 63, r32 = lane & 31, hi = lane >> 5;
    const int NT = (cur.P0 + QB) / KVBLK;
    const int qlo = cur.P0 + wid * QBLK, qm = qlo + r32 - 4 * hi;
    char* V_lds = lds; char* K_lds = lds + 2 * SHM_V;
    float* ws = (float*)(lds + 2 * SHM_V + 2 * SHM_K) + wid * 64; float* li_l = ws, * al_l = ws + 32;
    float m_reg = -1e30f, l_reg = 0; f32x16 o[4] = {};
    const int sr = tid >> 4, sc = (tid & 15) * 8;
    const int kr0 = tid >> 4, kc0 = (tid & 15) * 8, kr1 = kr0 + 32, kc1 = kc0, kr2 = tid >> 3, kc2 = 128 + (tid & 7) * 8;
    const int kws0 = KSWZ(kr0, kc0 * 2), kws1 = KSWZ(kr1, kc1 * 2), kws2 = KSWZ(kr2, kc2 * 2);
    const int vst0 = v_st(sr, sc), vst1 = v_st(32 + sr, sc);
    const int vb0 = (int)(uintptr_t)V_lds + v_rd_base(lane);
    const bf16_t* Kh = cur.K; const bf16_t* KRh = cur.KR; const bf16_t* Vh = cur.K + 128;
    StReg sA;
    bf16x8 qr[12];
#pragma unroll
    for (int d0 = 0; d0 < 12; ++d0) qr[d0] = load8(cur.Q + (size_t)(wid * QBLK + r32) * LDQ + d0 * 16 + hi * 8);
    SLOAD_H(sA, 0); VMW(); SWRITE_H(sA, 0);
    q_postproc(qr, qn, cur.tok0 + wid * QBLK + r32, hi);
    SLOAD_H(sA, KVBLK);
    asm volatile("s_waitcnt lgkmcnt(0)\n\ts_barrier" ::: "memory");
#define RESC(a) do { if (__any((a) < 1.f)) { if (hi == 0) al_l[r32] = (a); asm volatile("s_waitcnt lgkmcnt(0)" ::: "memory");              \
                     _Pragma("unroll") for (int d_ = 0; d_ < 4; ++d_) _Pragma("unroll") for (int r = 0; r < 16; ++r) o[d_][r] *= al_l[crow(r, hi)]; } } while (0)
#define KBASE(t) ((t) * KVBLK)
#define MASKT(P0_, P1_, t) do { const int kb_ = KBASE(t); if (kb_ + KVBLK - 1 > qlo) mask_tile(P0_, P1_, qm - kb_); } while (0)
    f32x16 p0, p1; float mn, al; bf16x8 pa0, pa1, pa2, pa3;
#define STEP(t, BUF, SN, SW) do {                                                                                             \
        SWRITE_H(sA, 1 - BUF);     \
        { const int tn_ = (t) + 2 < NT ? (t) + 2 : NT - 1; SLOAD_H(sA, KBASE(tn_)); }     \
        SBAR(); qkt<BUF>(p0, p1, K_lds, r32, hi, qr);                                                                         \
        MASKT(p0, p1, (t));                                                                                                   \
        if (STATIC) { staticSM(p0, p1, mB); _Pragma("unroll") for (int r_ = 0; r_ < 16; ++r_) p1[r_] = fmaf(p1[r_], 1.4426950408889634f * SCALE, -mB); finishSM(p0, p1, 1.0f, l_reg, pa0, pa1, pa2, pa3); } \
        else { partialSM(p0, p1, m_reg, mn, al); finishSM(p0, p1, al, l_reg, pa0, pa1, pa2, pa3); RESC(al); } SBAR();       \
        if (STATIC) pv_tile_pipe<BUF>(o, vb0, pa0, pa1, pa2, pa3); else pv_tile<BUF>(o, vb0, pa0, pa1, pa2, pa3);             \
        asm volatile("s_waitcnt lgkmcnt(0)\n\ts_barrier" ::: "memory"); } while (0)
    for (int t = 0; t < NT; t += 2) { STEP(t, 0, sA, sA); STEP(t + 1, 1, sA, sA); }
    if (hi == 0) li_l[r32] = l_reg; asm volatile("s_waitcnt lgkmcnt(0)" ::: "memory");
    float rli[16];
#pragma unroll
    for (int r = 0; r < 16; ++r) rli[r] = __builtin_amdgcn_rcpf(li_l[crow(r, hi)]);
    bf16_t* Ow = cur.O + (size_t)(wid * QBLK) * LDO;
#pragma unroll
    for (int r = 0; r < 16; ++r) { const int orow = crow(r, hi);
#pragma unroll
        for (int d0 = 0; d0 < 4; ++d0) { const float v = o[d0][r] * rli[r];
            const float vn = __shfl_xor(v, 1);
            if ((r32 & 1) == 0) *(unsigned*)(Ow + (size_t)orow * LDO + d0 * 32 + r32) = cvtpk(v, vn); } }
    __syncthreads();
#undef RESC
#undef KBASE
#undef MASKT
#undef STEP
}
#undef VMW
#undef SLOAD_H
#undef SWRITE_H
#undef SBAR
}
#define LAS __attribute__((address_space(3)))
typedef unsigned short bf16;
typedef float f32x4 __attribute__((ext_vector_type(4)));
typedef float f32x2 __attribute__((ext_vector_type(2)));
typedef float f32x16 __attribute__((ext_vector_type(16)));
typedef unsigned u32x4 __attribute__((ext_vector_type(4)));
typedef unsigned u32x2 __attribute__((ext_vector_type(2)));
typedef short bf16x8 __attribute__((ext_vector_type(8)));
typedef short s16x4 __attribute__((ext_vector_type(4)));
#ifndef PROBE_ATTN
#define PROBE_ATTN 0
#endif
#ifndef PROBE_FFNUP
#define PROBE_FFNUP 0
#endif
#ifndef PROBE_REP
#define PROBE_REP 0
#endif
#ifndef PROBE_SYNC
#define PROBE_SYNC 0
#endif
#ifndef PROBE_CO
#define PROBE_CO 0
#endif
#ifndef ONE_LAUNCH
#define ONE_LAUNCH 1
#endif
constexpr int NB = 2, SEQ = 16384, M = NB * SEQ, D = 1024, DFF = 2816, INC = 2768, INP = 2816, MIXK = 1024, NCHUNK = SEQ / 128;
constexpr float EPS = 1e-6f;
constexpr int NTHREADS = 512, LDS_BYTES = 147456;
constexpr int PH_PER_LAYER = 11, NPHASE = 2 * PH_PER_LAYER;
constexpr size_t MiB = 1u << 20;
constexpr size_t WS_W1 = 0;
constexpr size_t WS_W2 = WS_W1 + (size_t)5632 * 1024 * 2;
constexpr size_t WS_WIN = WS_W2 + (size_t)1024 * 2816 * 2;
constexpr size_t WS_WUQ = WS_WIN + (size_t)2816 * 1024 * 2;
constexpr size_t WS_WUKV = WS_WUQ + (size_t)768 * 384 * 2;
constexpr size_t WS_WOUT = WS_WUKV + (size_t)1024 * 256 * 2;
constexpr size_t WS_W3 = WS_WOUT + (size_t)1024 * 1280 * 2;
constexpr size_t WS_W4 = WS_W3 + (size_t)5632 * 1024 * 2;
constexpr size_t WS_WEND = WS_W4 + (size_t)1024 * 2816 * 2;
constexpr size_t WS_XB = 44 * MiB;
constexpr size_t OUT_KV = 0, OUT_QF = 64 * MiB;
constexpr size_t WS_A = WS_XB + 64 * MiB;
constexpr size_t WS_B = WS_A + 176 * MiB;
constexpr size_t WS_LOGA = WS_B, WS_URET = WS_B + 32 * MiB, WS_UGLA = WS_B + 48 * MiB, WS_GDEC = WS_B + 64 * MiB, WS_CQN = WS_B + 65 * MiB, WS_CKVN = WS_B + 89 * MiB, WS_KROPE = WS_B + 105 * MiB;
constexpr size_t WS_MIX = WS_B + 110 * MiB;
constexpr size_t WS_SSQ = WS_MIX + 64 * MiB;
constexpr size_t WS_ROPE = WS_SSQ + 2 * MiB;
constexpr size_t WS_CTL = WS_ROPE + 8 * MiB, CTL_BYTES = 16384;
constexpr size_t WS_END = WS_CTL + 1 * MiB;
static_assert(WS_WEND <= WS_XB && (size_t)M * 2816 * 2 <= 176 * MiB && WS_END <= 512 * MiB, "d_ws map");

__constant__ double INVF[32] = {1.0, 0.7498942093324559, 0.5623413251903491, 0.4216965034285822, 0.31622776601683794, 0.23713737056616552, 0.1778279410038923, 0.1333521432163324, 0.1, 0.07498942093324558, 0.05623413251903491, 0.042169650342858224, 0.03162277660168379, 0.023713737056616554, 0.01778279410038923, 0.01333521432163324, 0.01, 0.007498942093324558, 0.005623413251903491, 0.004216965034285823, 0.0031622776601683794, 0.0023713737056616554, 0.0017782794100389228, 0.001333521432163324, 0.001, 0.0007498942093324559, 0.0005623413251903491, 0.00042169650342858224, 0.00031622776601683794, 0.00023713737056616554, 0.00017782794100389227, 0.0001333521432163324};
__device__ __forceinline__ float ret_log2g(int h) { return h == 0 ? -0.04580368961312479f : h == 1 ? -0.02272007650008353f : h == 2 ? -0.011315313227834146f : -0.005646563141142063f; }

__device__ __forceinline__ unsigned f2bf(float f) { unsigned u = __builtin_bit_cast(unsigned, f); return (u + 0x7fffu + ((u >> 16) & 1u)) >> 16; }
__device__ __forceinline__ unsigned pk2(float lo, float hi) { return f2bf(lo) | (f2bf(hi) << 16); }
__device__ __forceinline__ float bflo(unsigned w) { return __builtin_bit_cast(float, w << 16); }
__device__ __forceinline__ float bfhi(unsigned w) { return __builtin_bit_cast(float, w & 0xffff0000u); }
__device__ __forceinline__ float bf2f(bf16 v) { return __builtin_bit_cast(float, (unsigned)v << 16); }
__device__ __forceinline__ float wave_sum(float v) {
#pragma unroll
    for (int o = 1; o < 64; o <<= 1) v += __shfl_xor(v, o);
    return v;
}
__device__ __forceinline__ float silu(float g) { return g * __builtin_amdgcn_rcpf(1.0f + __expf(-g)); }
#define MFMA32(a, b, c) __builtin_amdgcn_mfma_f32_32x32x16_bf16((a), (b), (c), 0, 0, 0)
__device__ __forceinline__ int crow(int r, int hi) { return (r & 3) + 8 * (r >> 2) + 4 * hi; }

struct Params { const float* in[23]; float* out; unsigned char* ws; int ph_lo, ph_hi; };
struct Frame {
    unsigned char* lds; int tid, lane, wave, G, bid;
    const float* in[23]; float* out; unsigned char* ws;
};

struct TrDesc { const float* W; const float* gain; bf16* WT; int ldw, ldt, k0, kdst0, scol0, nvalid, drow0; };
__device__ __forceinline__ void tr_load(const TrDesc& d, f32x4 (&v)[16], int lane) {
    const int nq = (lane & 15) * 4, kq = lane >> 4;
#pragma unroll
    for (int j = 0; j < 16; ++j) { const int kk = 8 * (j >> 1) + 2 * kq + (j & 1);
        v[j] = (f32x4){0.f, 0.f, 0.f, 0.f};
        if (nq < d.nvalid) v[j] = *(const f32x4*)(d.W + (size_t)(d.k0 + kk) * d.ldw + d.scol0 + nq); }
}
__device__ __forceinline__ void tr_store(const TrDesc& d, f32x4 (&v)[16], unsigned* scr, int lane) {
    const int nq = (lane & 15) * 4, kq = lane >> 4;
    if (d.gain) {
#pragma unroll
        for (int j = 0; j < 16; ++j) { const int kk = 8 * (j >> 1) + 2 * kq + (j & 1); v[j] *= d.gain[d.k0 + kk]; } }
#pragma unroll
    for (int m = 0; m < 8; ++m) { const int kp = 4 * m + kq;
#pragma unroll
        for (int c = 0; c < 4; ++c) scr[(nq + c) * 33 + kp] = pk2(v[2 * m][c], v[2 * m + 1][c]); }
    asm volatile("s_waitcnt lgkmcnt(0)" ::: "memory");
    const int cc = lane & 7;
#pragma unroll
    for (int r = 0; r < 8; ++r) { const int n = 8 * r + (lane >> 3); const unsigned* s = scr + n * 33 + 4 * cc;
        u32x4 o; o[0] = s[0]; o[1] = s[1]; o[2] = s[2]; o[3] = s[3];
        *(u32x4*)(d.WT + (size_t)(d.drow0 + n) * d.ldt + d.kdst0 + 8 * cc) = o; }
    asm volatile("s_waitcnt lgkmcnt(0)" ::: "memory");
}
constexpr int PI1 = 88 * 16, PI2 = 16 * 44, PI3 = 44 * 16, PI4 = 12 * 6, PI5 = 16 * 4, PI6 = 16 * 16;
constexpr int PNITEMS = 2 * PI1 + 2 * PI2 + PI3 + PI4 + PI5 + PI6;
__device__ __forceinline__ TrDesc tr_decode(Frame& F, int l, int it) {
    unsigned char* ws = F.ws; TrDesc d; int r = it;
    if (r < 2 * PI1) {
        const int which = r / PI1; r -= which * PI1; const int db = r / 16, kb = r % 16, pn = db >> 2, bj = (db >> 1) & 1, i64 = db & 1;
        d.W = (which ? F.in[21] : F.in[3]) + (size_t)l * 1024 * 5632; d.gain = (which ? F.in[20] : F.in[2]) + l * 1024; d.WT = (bf16*)(ws + (which ? WS_W3 : WS_W1));
        d.ldw = 5632; d.ldt = 1024; d.k0 = kb * 64; d.kdst0 = kb * 64; d.scol0 = bj * 2816 + pn * 128 + i64 * 64; d.nvalid = 64; d.drow0 = db * 64; return d; }
    r -= 2 * PI1;
    if (r < 2 * PI2) {
        const int which = r / PI2; r -= which * PI2; const int db = r / 44, kb = r % 44;
        d.W = (which ? F.in[22] : F.in[4]) + (size_t)l * 2816 * 1024; d.gain = nullptr; d.WT = (bf16*)(ws + (which ? WS_W4 : WS_W2));
        d.ldw = 1024; d.ldt = 2816; d.k0 = kb * 64; d.kdst0 = kb * 64; d.scol0 = db * 64; d.nvalid = 64; d.drow0 = db * 64; return d; }
    r -= 2 * PI2;
    if (r < PI3) {
        const int db = r / 16, kb = r % 16; int nv = INC - db * 64; nv = nv < 0 ? 0 : (nv > 64 ? 64 : nv);
        d.W = F.in[6] + (size_t)l * 1024 * INC; d.gain = F.in[5] + l * 1024; d.WT = (bf16*)(ws + WS_WIN);
        d.ldw = INC; d.ldt = 1024; d.k0 = kb * 64; d.kdst0 = kb * 64; d.scol0 = db * 64; d.nvalid = nv; d.drow0 = db * 64; return d; }
    r -= PI3;
    if (r < PI4) { const int db = r / 6, kb = r % 6;
        d.W = F.in[9] + (size_t)l * 384 * 768; d.gain = nullptr; d.WT = (bf16*)(ws + WS_WUQ);
        d.ldw = 768; d.ldt = 384; d.k0 = kb * 64; d.kdst0 = kb * 64; d.scol0 = db * 64; d.nvalid = 64; d.drow0 = db * 64; return d; }
    r -= PI4;
    if (r < PI5) { const int db = r / 4, kb = r % 4;
        d.W = F.in[11] + (size_t)l * 256 * 1024; d.gain = nullptr; d.WT = (bf16*)(ws + WS_WUKV);
        d.ldw = 1024; d.ldt = 256; d.k0 = kb * 64; d.kdst0 = kb * 64; d.scol0 = db * 64; d.nvalid = 64; d.drow0 = db * 64; return d; }
    r -= PI5;
    { const int db = r / 16, kb = r % 16;
        d.W = F.in[19] + (size_t)l * 1024 * 1024; d.gain = nullptr; d.WT = (bf16*)(ws + WS_WOUT);
        d.ldw = 1024; d.ldt = MIXK; d.k0 = kb * 64; d.kdst0 = kb * 64; d.scol0 = db * 64; d.nvalid = 64; d.drow0 = db * 64; return d; }
}
__device__ __forceinline__ void prep_phase(Frame& F, int l) {
    unsigned* scr = (unsigned*)(F.lds + F.wave * 8448);
    const int gw = F.bid * 8 + F.wave, NGW = F.G * 8;
    unsigned char* ws = F.ws;
    if (gw < PNITEMS) {
        f32x4 va[16], vb[16];
        TrDesc da = tr_decode(F, l, gw), db_; tr_load(da, va, F.lane);
        for (int it = gw; it < PNITEMS; it += 2 * NGW) {
            const int i1 = it + NGW, i2 = it + 2 * NGW;
            if (i1 < PNITEMS) { db_ = tr_decode(F, l, i1); tr_load(db_, vb, F.lane); }
            tr_store(da, va, scr, F.lane);
            if (i1 < PNITEMS) {
                if (i2 < PNITEMS) { da = tr_decode(F, l, i2); tr_load(da, va, F.lane); }
                tr_store(db_, vb, scr, F.lane);
            }
        }
    }
    if (l == 0) {
        const float* x = F.in[0]; bf16* xb = (bf16*)(ws + WS_XB); float* ssq = (float*)(ws + WS_SSQ);
        for (int m = gw; m < M; m += NGW) {
            const f32x4* xr = (const f32x4*)(x + (size_t)m * D) + F.lane; float s = 0.f;
            u32x2* o8 = (u32x2*)(xb + (size_t)m * D) + F.lane;
#pragma unroll
            for (int j = 0; j < 4; ++j) { const f32x4 v = xr[64 * j]; s += (v[0] * v[0] + v[1] * v[1]) + (v[2] * v[2] + v[3] * v[3]);
                u32x2 w; w[0] = pk2(v[0], v[1]); w[1] = pk2(v[2], v[3]); o8[64 * j] = w; }
            s = wave_sum(s);
            if (F.lane < 16) ssq[(size_t)m * 16 + F.lane] = F.lane == 0 ? s : 0.f;
        }
        const int* pos = (const int*)F.in[1]; float* rc = (float*)(ws + WS_ROPE); float* rsn = rc + (size_t)M * 32;
        for (int e = F.bid * NTHREADS + F.tid; e < M * 32; e += F.G * NTHREADS) {
            const int tok = e >> 5, i = e & 31;
            const double ang = (double)pos[tok] * INVF[i]; double rev = ang * 0.15915494309189535; rev -= __builtin_floor(rev);
            const float rf = (float)rev;
            rc[e] = __builtin_amdgcn_cosf(rf); rsn[e] = __builtin_amdgcn_sinf(rf);
        }
    }
}

struct P1Tok { unsigned cq[3]; u32x2 ckv; u32x4 al0, al1; float c1, s1; bf16 kr; };
__device__ __forceinline__ P1Tok p1_load(const bf16* proj, const float* rc, const float* rsn, int tok, int lane) {
    P1Tok t; const bf16* p = proj + (size_t)tok * INP;
#pragma unroll
    for (int j = 0; j < 3; ++j) t.cq[j] = *(const unsigned*)(p + 1024 + 128 * j + 2 * lane);
    t.ckv = *(const u32x2*)(p + 1408 + 4 * lane); t.kr = p[1664 + lane];
    t.al0 = *(const u32x4*)(p + 2496); t.al1 = *(const u32x4*)(p + 2504);
    t.c1 = rc[(size_t)tok * 32 + (lane & 31)]; t.s1 = rsn[(size_t)tok * 32 + (lane & 31)];
    return t;
}
__device__ __forceinline__ void post1_phase(Frame& F, int l) {
    unsigned char* ws = F.ws; const int lane = F.lane;
    const bf16* proj = (const bf16*)(ws + WS_A);
    bf16 *cqn = (bf16*)(ws + WS_CQN), *ckvn = (bf16*)(ws + WS_CKVN), *krope = (bf16*)(ws + WS_KROPE);
    float* loga = (float*)(ws + WS_LOGA);
    const float* rc = (const float*)(ws + WS_ROPE); const float* rsn = rc + (size_t)M * 32;
    const float* g_q = F.in[8] + l * 384; const float* g_kv = F.in[10] + l * 256; const float* g_kr = F.in[15] + l * 64;
    const float* Wg = F.in[16] + (size_t)l * 16 * 256; const float* bg = F.in[17] + l * 256;
    const int gw = F.bid * 8 + F.wave, NGW = F.G * 8;
    f32x4 wgr[16];
#pragma unroll
    for (int r = 0; r < 16; ++r) wgr[r] = *(const f32x4*)(Wg + r * 256 + 4 * lane);
    const f32x4 bias = *(const f32x4*)(bg + 4 * lane), gkv = *(const f32x4*)(g_kv + 4 * lane);
    float gq[6];
#pragma unroll
    for (int j = 0; j < 3; ++j) { gq[2 * j] = g_q[128 * j + 2 * lane]; gq[2 * j + 1] = g_q[128 * j + 2 * lane + 1]; }
    const float gkr = g_kr[lane];
    if (gw >= M) return;
    P1Tok t = p1_load(proj, rc, rsn, gw, lane);
    for (int tok = gw; tok < M; tok += NGW) {
        const int tn = tok + NGW < M ? tok + NGW : tok;
        const P1Tok nx = p1_load(proj, rc, rsn, tn, lane);
        float ssq_ = 0.f;
#pragma unroll
        for (int j = 0; j < 3; ++j) { const float x0 = bflo(t.cq[j]), x1 = bfhi(t.cq[j]); ssq_ += x0 * x0 + x1 * x1; }
        const float k0 = bflo(t.ckv[0]), k1 = bfhi(t.ckv[0]), k2 = bflo(t.ckv[1]), k3 = bfhi(t.ckv[1]);
        float sskv = (k0 * k0 + k1 * k1) + (k2 * k2 + k3 * k3);
        const float v = bf2f(t.kr); float sskr = v * v;
#pragma unroll
        for (int o = 1; o < 64; o <<= 1) { ssq_ += __shfl_xor(ssq_, o); sskv += __shfl_xor(sskv, o); sskr += __shfl_xor(sskr, o); }
        { const float r = rsqrtf(ssq_ * (1.0f / 384.0f) + EPS);
#pragma unroll
          for (int j = 0; j < 3; ++j) *(unsigned*)(cqn + (size_t)tok * 384 + 128 * j + 2 * lane) = pk2(bflo(t.cq[j]) * r * gq[2 * j], bfhi(t.cq[j]) * r * gq[2 * j + 1]); }
        { const float r = rsqrtf(sskv * (1.0f / 256.0f) + EPS); u32x2 o; o[0] = pk2(k0 * r * gkv[0], k1 * r * gkv[1]); o[1] = pk2(k2 * r * gkv[2], k3 * r * gkv[3]);
          *(u32x2*)(ckvn + (size_t)tok * 256 + 4 * lane) = o; }
        { const float r = rsqrtf(sskr * (1.0f / 64.0f) + EPS); const float vn = v * r * gkr; const float other = __shfl_xor(vn, 32);
          const float o = lane < 32 ? vn * t.c1 - other * t.s1 : other * t.s1 + vn * t.c1; krope[(size_t)tok * 64 + lane] = (bf16)f2bf(o); }
        {
            float al[16];
#pragma unroll
            for (int j = 0; j < 4; ++j) { al[2 * j] = bflo(t.al0[j]); al[2 * j + 1] = bfhi(t.al0[j]); al[8 + 2 * j] = bflo(t.al1[j]); al[9 + 2 * j] = bfhi(t.al1[j]); }
            f32x4 x = bias;
#pragma unroll
            for (int r = 0; r < 16; ++r) x += wgr[r] * al[r];
            f32x4 o;
#pragma unroll
            for (int j = 0; j < 4; ++j) { const float xv = x[j]; o[j] = (fminf(xv, 0.f) - __logf(1.0f + __expf(-fabsf(xv)))) * (1.0f / 16.0f); }
            *(f32x4*)(loga + (size_t)tok * 256 + 4 * lane) = o;
        }
        t = nx;
    }
}

struct P2Tok { unsigned ka[4]; };
__device__ __forceinline__ P2Tok p2_load(const bf16* kv, int tok, int lane) {
    P2Tok t; const bf16* kvp = kv + (size_t)tok * 1024;
#pragma unroll
    for (int h = 0; h < 4; ++h) t.ka[h] = *(const unsigned*)(kvp + h * 256 + 2 * lane);
    return t;
}
__device__ __forceinline__ void post2_phase(Frame& F, int l) {
    const int lane = F.lane;
    bf16* kv = (bf16*)((unsigned char*)F.out + OUT_KV);
    const float* g_kn = F.in[14] + l * 128;
    const int gw = F.bid * 8 + F.wave, NGW = F.G * 8;
    const float gk0 = g_kn[2 * lane], gk1 = g_kn[2 * lane + 1];
    if (gw >= M) return;
    P2Tok t = p2_load(kv, gw, lane);
    for (int tok = gw; tok < M; tok += NGW) {
        const int tn = tok + NGW < M ? tok + NGW : tok;
        const P2Tok nx = p2_load(kv, tn, lane);
        bf16* kd = kv + (size_t)tok * 1024;
        float s3[4];
#pragma unroll
        for (int h = 0; h < 4; ++h) { const float k0 = bflo(t.ka[h]), k1 = bfhi(t.ka[h]); s3[h] = k0 * k0 + k1 * k1; }
#pragma unroll
        for (int o = 1; o < 64; o <<= 1)
#pragma unroll
            for (int h = 0; h < 4; ++h) s3[h] += __shfl_xor(s3[h], o);
#pragma unroll
        for (int h = 0; h < 4; ++h) { const float k0 = bflo(t.ka[h]), k1 = bfhi(t.ka[h]); const float r3 = rsqrtf(s3[h] * (1.0f / 128.0f) + EPS);
            *(unsigned*)(kd + h * 256 + 2 * lane) = pk2(k0 * r3 * gk0, k1 * r3 * gk1); }
        t = nx;
    }
}
constexpr int LQ = 72, LT = 136, LB = 65;
__device__ __forceinline__ void gla_cumsum_regs(const f32x4 (&la)[4], float* Bc, int tid) {
#pragma unroll
    for (int i = 0; i < 4; ++i) { const int idx = tid + 512 * i, t = idx >> 4, c4 = (idx & 15) * 4;
        Bc[t * LB + c4] = la[i][0]; Bc[t * LB + c4 + 1] = la[i][1]; Bc[t * LB + c4 + 2] = la[i][2]; Bc[t * LB + c4 + 3] = la[i][3]; }
    __syncthreads();
    const int d = tid & 63, seg = tid >> 6; float run = 0.f;
#pragma unroll
    for (int j = 0; j < 16; ++j) { run += Bc[(16 * seg + j) * LB + d]; Bc[(16 * seg + j) * LB + d] = run; }
    __syncthreads();
    float off = 0.f;
    for (int s2 = 0; s2 < seg; ++s2) off += Bc[(16 * s2 + 15) * LB + d];
    __syncthreads();
#pragma unroll
    for (int j = 0; j < 16; ++j) Bc[(16 * seg + j) * LB + d] += off;
    __syncthreads();
}
struct CsRegs { bf16x8 k[2], v[2]; f32x4 la[4]; };
__device__ __forceinline__ void cs_load(CsRegs& R, unsigned char* ws, int it, int tid) {
    const bool gla = it >= 1024; const int ch = it & 1023, b = ch >> 9, h = (ch >> 7) & 3, n = ch & 127, t0 = b * SEQ + n * 128;
    const bf16* proj = (const bf16*)(ws + WS_A); const int koff = (gla ? 1984 : 256) + h * 64, voff = (gla ? 2240 : 512) + h * 64;
    const int s = tid & 127, cq = (tid >> 7) * 8; const bf16* row = proj + (size_t)(t0 + s) * INP;
    R.k[0] = *(const bf16x8*)(row + koff + cq); R.k[1] = *(const bf16x8*)(row + koff + 32 + cq);
    R.v[0] = *(const bf16x8*)(row + voff + cq); R.v[1] = *(const bf16x8*)(row + voff + 32 + cq);
    if (gla) { const float* loga = (const float*)(ws + WS_LOGA);
#pragma unroll
        for (int i = 0; i < 4; ++i) { const int idx = tid + 512 * i, t = idx >> 4, c4 = (idx & 15) * 4; R.la[i] = *(const f32x4*)(loga + (size_t)(t0 + t) * 256 + h * 64 + c4); } }
    else { const float* rc = (const float*)(ws + WS_ROPE) + (size_t)(t0 + s) * 32 + cq; const float* rsn = rc + (size_t)M * 32;
        R.la[0] = *(const f32x4*)rc; R.la[1] = *(const f32x4*)(rc + 4); R.la[2] = *(const f32x4*)rsn; R.la[3] = *(const f32x4*)(rsn + 4); }
}
__device__ __forceinline__ void chunk_state_phase(Frame& F) {
    unsigned char* ws = F.ws;
    bf16* Vt = (bf16*)F.lds; bf16* Kt = (bf16*)(F.lds + 17408); float* Bc = (float*)(F.lds + 34816);
    float* gdec = (float*)(ws + WS_GDEC);
    int it = F.bid; if (it >= 2048) return;
    CsRegs R; cs_load(R, ws, it, F.tid);
    for (; it < 2048; it += F.G) {
        int tid = F.tid; asm volatile("" : "+v"(tid)); const int lane = tid & 63, r32 = lane & 31, hi = lane >> 5;
        const bool gla = it >= 1024; const int ch = it & 1023, h = (ch >> 7) & 3;
        float* U = (float*)(ws + (gla ? WS_UGLA : WS_URET));
        if (gla) gla_cumsum_regs(R.la, Bc, tid);
        const float l2g = ret_log2g(h);
        { const int s = tid & 127, cq = (tid >> 7) * 8;
            const float zr = __builtin_amdgcn_exp2f((float)(127 - s) * l2g) * 0.125f;
#pragma unroll
            for (int j = 0; j < 8; ++j) { Vt[(cq + j) * LT + s] = (bf16)R.v[0][j]; Vt[(32 + cq + j) * LT + s] = (bf16)R.v[1][j];
                const float x1 = bf2f((bf16)R.k[0][j]), x2 = bf2f((bf16)R.k[1][j]); float k1, k2;
                if (gla) { k1 = x1 * __expf(Bc[127 * LB + cq + j] - Bc[s * LB + cq + j]); k2 = x2 * __expf(Bc[127 * LB + 32 + cq + j] - Bc[s * LB + 32 + cq + j]); }
                else { const float cc = R.la[j >> 2][j & 3], sn = R.la[2 + (j >> 2)][j & 3]; k1 = (x1 * cc - x2 * sn) * zr; k2 = (x1 * sn + x2 * cc) * zr; }
                Kt[(cq + j) * LT + s] = (bf16)f2bf(k1); Kt[(32 + cq + j) * LT + s] = (bf16)f2bf(k2); } }
        __syncthreads();
        if (it + F.G < 2048) cs_load(R, ws, it + F.G, tid);
        if (F.wave < 4) { const int vt = F.wave >> 1, dt = F.wave & 1; f32x16 acc = {};
#pragma unroll
            for (int ks = 0; ks < 8; ++ks) { const bf16x8 a = *(const bf16x8*)(Vt + (32 * vt + r32) * LT + 16 * ks + 8 * hi), bb = *(const bf16x8*)(Kt + (32 * dt + r32) * LT + 16 * ks + 8 * hi);
                acc = MFMA32(a, bb, acc); }
#pragma unroll
            for (int r = 0; r < 16; ++r) U[(size_t)ch * 4096 + (32 * vt + crow(r, hi)) * 64 + 32 * dt + r32] = acc[r];
        }
        if (gla && tid < 64) gdec[ch * 64 + tid] = __expf(Bc[127 * LB + tid]);
        __syncthreads();
    }
}
__device__ __forceinline__ void scan_phase(Frame& F) {
    unsigned char* ws = F.ws; const float* gdec = (const float*)(ws + WS_GDEC);
    float* sumD = (float*)F.lds; float* sumE = sumD + 512;
    const int tid = F.tid, g = tid >> 6, el = tid & 63;
    for (int blk = F.bid; blk < 1024; blk += F.G) {
        const int type = blk >> 9, bh = (blk >> 6) & 7, e = (blk & 63) * 64 + el;
        float* U = (float*)(ws + (type ? WS_UGLA : WS_URET)) + (size_t)(bh * 128 + 16 * g) * 4096 + e;
        const float dret = __builtin_amdgcn_exp2f(128.0f * ret_log2g(bh & 3));
        float u[16], dc[16];
#pragma unroll
        for (int j = 0; j < 16; ++j) { u[j] = U[(size_t)j * 4096]; dc[j] = type ? gdec[(bh * 128 + 16 * g + j) * 64 + (e & 63)] : dret; }
        float D = 1.f, E = 0.f;
#pragma unroll
        for (int j = 0; j < 16; ++j) { E = E * dc[j] + u[j]; D *= dc[j]; }
        sumD[tid] = D; sumE[tid] = E;
        __syncthreads();
        float cur = 0.f;
        for (int g2 = 0; g2 < g; ++g2) cur = cur * sumD[g2 * 64 + el] + sumE[g2 * 64 + el];
#pragma unroll
        for (int j = 0; j < 16; ++j) { U[(size_t)j * 4096] = cur; cur = cur * dc[j] + u[j]; }
        __syncthreads();
    }
}
struct CoRegs { bf16x8 q[2], k[2], v[2]; f32x4 u[2]; f32x4 la[4]; };
__device__ __forceinline__ void co_load(CoRegs& R, unsigned char* ws, int it, int tid) {
    const bool gla = it >= 1024; const int ch = it & 1023, b = ch >> 9, h = (ch >> 7) & 3, n = ch & 127, t0 = b * SEQ + n * 128;
    const bf16* proj = (const bf16*)(ws + WS_A);
    const int qoff = (gla ? 1728 : 0) + h * 64, koff = (gla ? 1984 : 256) + h * 64, voff = (gla ? 2240 : 512) + h * 64;
    const float* U = (const float*)(ws + (gla ? WS_UGLA : WS_URET));
    { const int t = tid >> 2, cq = (tid & 3) * 8; const bf16* row = proj + (size_t)(t0 + t) * INP;
      R.q[0] = *(const bf16x8*)(row + qoff + cq); R.q[1] = *(const bf16x8*)(row + qoff + 32 + cq); R.k[0] = *(const bf16x8*)(row + koff + cq); R.k[1] = *(const bf16x8*)(row + koff + 32 + cq);
      if (!gla) { const float* rc = (const float*)(ws + WS_ROPE) + (size_t)(t0 + t) * 32 + cq; const float* rsn = rc + (size_t)M * 32;
          R.la[0] = *(const f32x4*)rc; R.la[1] = *(const f32x4*)(rc + 4); R.la[2] = *(const f32x4*)rsn; R.la[3] = *(const f32x4*)(rsn + 4); } }
    { const int s = tid & 127, cv = (tid >> 7) * 8; const bf16* row = proj + (size_t)(t0 + s) * INP; R.v[0] = *(const bf16x8*)(row + voff + cv); R.v[1] = *(const bf16x8*)(row + voff + 32 + cv); }
#pragma unroll
    for (int i = 0; i < 2; ++i) { const int idx = tid + 512 * i, v = idx >> 4, c4 = (idx & 15) * 4; R.u[i] = *(const f32x4*)(U + (size_t)ch * 4096 + v * 64 + c4); }
    if (gla) { const float* loga = (const float*)(ws + WS_LOGA);
#pragma unroll
        for (int i = 0; i < 4; ++i) { const int idx = tid + 512 * i, t = idx >> 4, c4 = (idx & 15) * 4; R.la[i] = *(const f32x4*)(loga + (size_t)(t0 + t) * 256 + h * 64 + c4); } }
}
__device__ __forceinline__ void chunk_out_phase(Frame& F, int l) {
    unsigned char* ws = F.ws;
    bf16* Qs = (bf16*)F.lds; bf16* Ks = (bf16*)(F.lds + 18432); bf16* Vt = (bf16*)(F.lds + 36864); bf16* St = (bf16*)(F.lds + 54272); bf16* Q2 = (bf16*)(F.lds + 63488); float* Bc = (float*)(F.lds + 81920);
    bf16* mix = (bf16*)(ws + WS_MIX); const bf16* proj = (const bf16*)(ws + WS_A);
    int it = F.bid; if (it >= 2048) return;
    CoRegs R; co_load(R, ws, it, F.tid);
    for (; it < 2048; it += F.G) {
        int tid = F.tid; asm volatile("" : "+v"(tid)); const int lane = tid & 63, r32 = lane & 31, hi = lane >> 5;
        const bool gla = it >= 1024; const int ch = it & 1023, b = ch >> 9, h = (ch >> 7) & 3, n = ch & 127, t0 = b * SEQ + n * 128;
        const int mixoff = gla ? 768 : 0, goff = gla ? 2512 : 768;
        const float* gain = (gla ? F.in[18] : F.in[7]) + l * 256;
        if (gla) gla_cumsum_regs(R.la, Bc, tid);
        const float l2g = gla ? 0.f : ret_log2g(h);
        { const int t = tid >> 2, cq = (tid & 3) * 8;
          bf16x8 qa, qb, ka, kb, q2a, q2b;
          if (gla) {
#pragma unroll
              for (int j = 0; j < 8; ++j) {
                  const float bt0 = Bc[t * LB + cq + j], bm0 = Bc[63 * LB + cq + j], bt1 = Bc[t * LB + 32 + cq + j], bm1 = Bc[63 * LB + 32 + cq + j];
                  const float q0 = bf2f((bf16)R.q[0][j]) * 0.125f, q1 = bf2f((bf16)R.q[1][j]) * 0.125f, k0 = bf2f((bf16)R.k[0][j]), k1 = bf2f((bf16)R.k[1][j]);
                  q2a[j] = (short)f2bf(q0 * __expf(bt0)); qa[j] = (short)f2bf(q0 * __expf(bt0 - bm0)); ka[j] = (short)f2bf(k0 * __expf(bm0 - bt0));
                  q2b[j] = (short)f2bf(q1 * __expf(bt1)); qb[j] = (short)f2bf(q1 * __expf(bt1 - bm1)); kb[j] = (short)f2bf(k1 * __expf(bm1 - bt1)); }
          } else { const float xi = __builtin_amdgcn_exp2f((float)(t + 1) * l2g);
#pragma unroll
              for (int j = 0; j < 8; ++j) { const float cc = R.la[j >> 2][j & 3], sn = R.la[2 + (j >> 2)][j & 3];
                  const float x1 = bf2f((bf16)R.q[0][j]), x2 = bf2f((bf16)R.q[1][j]), y1 = bf2f((bf16)R.k[0][j]), y2 = bf2f((bf16)R.k[1][j]);
                  const float q0 = x1 * cc - x2 * sn, q1 = x1 * sn + x2 * cc, k0 = (y1 * cc - y2 * sn) * 0.125f, k1 = (y1 * sn + y2 * cc) * 0.125f;
                  qa[j] = (short)f2bf(q0); qb[j] = (short)f2bf(q1); ka[j] = (short)f2bf(k0); kb[j] = (short)f2bf(k1); q2a[j] = (short)f2bf(q0 * xi); q2b[j] = (short)f2bf(q1 * xi); } }
          *(bf16x8*)(Qs + t * LQ + cq) = qa; *(bf16x8*)(Qs + t * LQ + 32 + cq) = qb; *(bf16x8*)(Ks + t * LQ + cq) = ka; *(bf16x8*)(Ks + t * LQ + 32 + cq) = kb;
          *(bf16x8*)(Q2 + t * LQ + cq) = q2a; *(bf16x8*)(Q2 + t * LQ + 32 + cq) = q2b; }
        { const int s = tid & 127, cv = (tid >> 7) * 8;
#pragma unroll
          for (int j = 0; j < 8; ++j) { Vt[(cv + j) * LT + s] = (bf16)R.v[0][j]; Vt[(32 + cv + j) * LT + s] = (bf16)R.v[1][j]; } }
#pragma unroll
        for (int i = 0; i < 2; ++i) { const int idx = tid + 512 * i, v = idx >> 4, c4 = (idx & 15) * 4; const f32x4 sv = R.u[i];
            u32x2 w; w[0] = pk2(sv[0], sv[1]); w[1] = pk2(sv[2], sv[3]); *(u32x2*)(St + v * LQ + c4) = w; }
        __syncthreads();
        if (it + F.G < 2048) co_load(R, ws, it + F.G, tid);
        if (F.wave < 4) { const int tr = F.wave;
            unsigned gt[16];
#pragma unroll
            for (int r = 0; r < 16; ++r) { const bf16* gp = proj + (size_t)(t0 + 32 * tr + crow(r, hi)) * INP + goff + h * 64; gt[r] = (unsigned)gp[r32] | ((unsigned)gp[32 + r32] << 16); }
            const float gn0 = gain[h * 64 + r32], gn1 = gain[h * 64 + 32 + r32];
            f32x16 oi[2] = {};
            const int tl = 32 * tr + r32;
            for (int sj = 0; sj <= (tr >> 1); ++sj) {
                f32x16 p0 = {}, p1 = {};
#pragma unroll
                for (int ks = 0; ks < 4; ++ks) { const bf16x8 bq = *(const bf16x8*)(Qs + tl * LQ + 16 * ks + 8 * hi);
                    const bf16x8 a0 = *(const bf16x8*)(Ks + (64 * sj + r32) * LQ + 16 * ks + 8 * hi), a1 = *(const bf16x8*)(Ks + (64 * sj + 32 + r32) * LQ + 16 * ks + 8 * hi);
                    p0 = MFMA32(a0, bq, p0); p1 = MFMA32(a1, bq, p1); }
#pragma unroll
                for (int r = 0; r < 16; ++r) { const int s0 = 64 * sj + crow(r, hi), df0 = tl - s0, df1 = df0 - 32;
                    const float w0 = __builtin_amdgcn_exp2f((float)df0 * l2g), w1 = __builtin_amdgcn_exp2f((float)df1 * l2g);
                    p0[r] = df0 >= 0 ? p0[r] * w0 : 0.f; p1[r] = df1 >= 0 ? p1[r] * w1 : 0.f; }
#pragma unroll
                for (int q4 = 0; q4 < 4; ++q4) { const int st = (q4 & 1) * 8; u32x4 aw;
                    if (q4 < 2) { aw[0] = pk2(p0[st], p0[st + 1]); aw[1] = pk2(p0[st + 2], p0[st + 3]); aw[2] = pk2(p0[st + 4], p0[st + 5]); aw[3] = pk2(p0[st + 6], p0[st + 7]); }
                    else        { aw[0] = pk2(p1[st], p1[st + 1]); aw[1] = pk2(p1[st + 2], p1[st + 3]); aw[2] = pk2(p1[st + 4], p1[st + 5]); aw[3] = pk2(p1[st + 6], p1[st + 7]); }
                    const bf16x8 a = __builtin_bit_cast(bf16x8, aw); const int sb = 64 * sj + 16 * q4;
#pragma unroll
                    for (int vc = 0; vc < 2; ++vc) { const bf16* vp = Vt + (32 * vc + r32) * LT + sb + 4 * hi;
                        const s16x4 lo = *(const s16x4*)vp, hh = *(const s16x4*)(vp + 8);
                        const bf16x8 bv = {lo[0], lo[1], lo[2], lo[3], hh[0], hh[1], hh[2], hh[3]};
                        oi[vc] = MFMA32(a, bv, oi[vc]); } }
            }
#pragma unroll
            for (int ks = 0; ks < 4; ++ks) { const bf16x8 a = *(const bf16x8*)(Q2 + tl * LQ + 16 * ks + 8 * hi);
#pragma unroll
                for (int vc = 0; vc < 2; ++vc) { const bf16x8 bs = *(const bf16x8*)(St + (32 * vc + r32) * LQ + 16 * ks + 8 * hi); oi[vc] = MFMA32(a, bs, oi[vc]); } }
#pragma unroll
            for (int r = 0; r < 16; ++r) { const int tt = 32 * tr + crow(r, hi);
                const float o0 = oi[0][r], o1 = oi[1][r];
                float ss = o0 * o0 + o1 * o1;
                ss += __shfl_xor(ss, 1); ss += __shfl_xor(ss, 2); ss += __shfl_xor(ss, 4); ss += __shfl_xor(ss, 8); ss += __shfl_xor(ss, 16);
                const float rstd = rsqrtf(ss * (1.0f / 64.0f) + EPS);
                bf16* mp = mix + (size_t)(t0 + tt) * MIXK + mixoff + h * 64;
                mp[r32] = (bf16)f2bf(o0 * rstd * gn0 * silu(bflo(gt[r]))); mp[32 + r32] = (bf16)f2bf(o1 * rstd * gn1 * silu(bfhi(gt[r]))); }
        }
        __syncthreads();
    }
}
#define XB_TMO      128
#define XB_XCNT(j)  (256  + 64 * (j))
#define XB_XSUB(j)  (1280 + 64 * (j))
#define XB_XGEN(j)  (2304 + 64 * (j))
#define XB_TOP      3328
#define XB_TOPGEN   3392
#define XCD_BAR_WORDS 3456
#define XB_SPIN_CAP (1u << 18)

__device__ __forceinline__ unsigned xb_ld(unsigned* p)              { return __hip_atomic_load(p, __ATOMIC_RELAXED, __HIP_MEMORY_SCOPE_AGENT); }
__device__ __forceinline__ unsigned xb_add(unsigned* p, unsigned v) { return __hip_atomic_fetch_add(p, v, __ATOMIC_RELAXED, __HIP_MEMORY_SCOPE_AGENT); }
__device__ __forceinline__ unsigned xb_xcc_id() { return (unsigned)__builtin_amdgcn_s_getreg((3 << 11) | 20) & 0xFu; }
#define XB_SPIN(cond, bar) do { unsigned _sp = 0; while (cond) { __builtin_amdgcn_s_sleep(1); \
    if ((++_sp & 255u) == 0u) { if (xb_ld(&(bar)[XB_TMO])) break; if (_sp > XB_SPIN_CAP) { atomicAdd(&(bar)[XB_TMO], 1u); break; } } } } while (0)

struct XcdBarrier {
    unsigned* bar; unsigned x;
    volatile LAS unsigned* st;
};

__device__ __forceinline__ XcdBarrier xcd_barrier_post(unsigned* bar, volatile LAS unsigned* st) {
    XcdBarrier b; b.bar = bar; b.x = xb_xcc_id(); b.st = st;
    if (threadIdx.x == 0) (void)xb_add(&bar[XB_XCNT(b.x)], 1u);
    return b;
}
__device__ __forceinline__ void xcd_barrier_complete(unsigned* bar, unsigned x, unsigned& nloc, unsigned& nx) {
    const unsigned G = gridDim.x * gridDim.y * gridDim.z;
    unsigned sum, cnt, mine, sp = 0u;
    for (;;) {
        sum = 0u; cnt = 0u; mine = 0u;
#pragma unroll
        for (unsigned j = 0; j < 16; ++j) { const unsigned c = xb_ld(&bar[XB_XCNT(j)]); sum += c; cnt += (c > 0u) ? 1u : 0u; mine = (j == x) ? c : mine; }
        if (sum == G) break;
        __builtin_amdgcn_s_sleep(1);
        if ((++sp & 255u) == 0u) { if (xb_ld(&bar[XB_TMO])) break; if (sp > XB_SPIN_CAP) { atomicAdd(&bar[XB_TMO], 1u); break; } }
    }
    nloc = mine > 0u ? mine : 1u; nx = cnt > 0u ? cnt : 1u;
}

__device__ __forceinline__ void xcd_barrier(const XcdBarrier& b) {
    asm volatile("s_waitcnt vmcnt(0)" ::: "memory");
    __syncthreads();
    if (threadIdx.x == 0) {
        unsigned* bar = b.bar;
        __builtin_amdgcn_s_waitcnt(0);
        unsigned nloc = b.st[0], nx = b.st[1];
        if (nloc == 0u) { xcd_barrier_complete(bar, b.x, nloc, nx); b.st[0] = nloc; b.st[1] = nx; }
        const unsigned old = xb_add(&bar[XB_XSUB(b.x)], 1u);
        const unsigned gen = old / nloc;
        if (old + 1u == (gen + 1u) * nloc) {
            __builtin_amdgcn_fence(__ATOMIC_RELEASE, "agent");
            asm volatile("s_waitcnt vmcnt(0)" ::: "memory");
            const unsigned og = xb_add(&bar[XB_TOP], 1u);
            const unsigned tg = og / nx;
            if (og + 1u == (tg + 1u) * nx) xb_add(&bar[XB_TOPGEN], 1u);
            else XB_SPIN(xb_ld(&bar[XB_TOPGEN]) == tg, bar);
            __builtin_amdgcn_fence(__ATOMIC_ACQUIRE, "agent");
            xb_add(&bar[XB_XGEN(b.x)], 1u);
            asm volatile("s_waitcnt vmcnt(0)" ::: "memory");
        } else {
            XB_SPIN(xb_ld(&bar[XB_XGEN(b.x)]) == gen, bar);
            __builtin_amdgcn_fence(__ATOMIC_ACQUIRE, "agent");
            asm volatile("s_waitcnt vmcnt(0)" ::: "memory");
        }
    }
    __syncthreads();
}
__device__ __forceinline__ att::BlockRef mk_attn_ref(unsigned char* ws, unsigned char* ob, int L, int pass, bool dummy = false) {
    const int bh = L >> 5, x = L & 31, qb = pass ? x : 63 - x, b = bh >> 2, h = bh & 3;
    att::BlockRef r;
    r.Q = (const bf16*)(ob + OUT_QF) + (size_t)(b * SEQ + qb * 256) * 768 + h * 192;
    r.O = (bf16*)(ws + WS_MIX) + (size_t)(b * SEQ + qb * 256) * MIXK + 256 + h * 128;
    r.K = (const bf16*)(ob + OUT_KV) + (size_t)(b * SEQ) * 1024 + h * 256;
    r.KR = (const bf16*)(ws + WS_KROPE) + (size_t)(b * SEQ) * 64;
    r.P0 = qb * 256; r.tok0 = b * SEQ + qb * 256;
    return r;
}
__device__ __forceinline__ void attn_phase(Frame& F, int l, bool dummy = false) {
    const int G = F.G, vcu = (G % 8 == 0) ? (F.bid % 8) * (G / 8) + F.bid / 8 : F.bid;
    float gq = 0.f, gr = 0.f, gk = 0.f, gkr = 0.f;
    { const float* a = F.in[12] + l * 128; const float* b = F.in[13] + l * 64; const float* c = F.in[14] + l * 128; const float* d = F.in[15] + l * 64;
      gq = fmaxf(fabsf(a[F.lane]), fabsf(a[64 + F.lane])); gk = fmaxf(fabsf(c[F.lane]), fabsf(c[64 + F.lane])); gr = fabsf(b[F.lane]); gkr = fabsf(d[F.lane]);
#pragma unroll
      for (int o = 1; o < 64; o <<= 1) { gq = fmaxf(gq, __shfl_xor(gq, o)); gk = fmaxf(gk, __shfl_xor(gk, o)); gr = fmaxf(gr, __shfl_xor(gr, o)); gkr = fmaxf(gkr, __shfl_xor(gkr, o)); } }
    const float bound = 1.03f * att::SCALE * sqrtf(128.f * gq * gq + 64.f * gr * gr) * sqrtf(128.f * gk * gk + 64.f * gkr * gkr);
    const float mB = bound * 1.4426950408889634f;
    att::QNorm qn; qn.gqn = F.in[12] + l * 128; qn.gkn = F.in[14] + l * 128; qn.gqr = F.in[13] + l * 64; qn.rc = (const float*)(F.ws + WS_ROPE); qn.rsn = qn.rc + (size_t)M * 32;
    const bool use_static = bound < 40.0f;
    for (int L = vcu; L < 256; L += G)
        for (int pass = 0; pass < 2; ++pass) { const att::BlockRef cur = mk_attn_ref(F.ws, (unsigned char*)F.out, L, pass, dummy);
            if (use_static) att::attn_block<true>(cur, (char*)F.lds, mB, qn); else att::attn_block<false>(cur, (char*)F.lds, mB, qn); }
}

__global__ void __launch_bounds__(NTHREADS) mega_fwd(Params p) {
    extern __shared__ __attribute__((aligned(16))) unsigned char lds[];
    cg::grid_group grid = cg::this_grid();
    PG8_LAS unsigned char* ring = (PG8_LAS unsigned char*)lds;
    volatile LAS unsigned* bst = (volatile LAS unsigned*)((LAS unsigned char*)lds + 131072 + 256);
    if (threadIdx.x < 2) bst[threadIdx.x] = 0u;
    __syncthreads();
    XcdBarrier xbar = xcd_barrier_post((unsigned*)(p.ws + WS_CTL), bst);
    int rep = 0; (void)rep;
#if PROBE_SYNC
    for (int i = 0; i < PROBE_SYNC; ++i) xcd_barrier(xbar);
#endif
    for (int ph = p.ph_lo; ph < p.ph_hi; ++ph) {
        int tid_ = threadIdx.x, bid_ = blockIdx.x, G_ = gridDim.x;
        __attribute__((address_space(1))) unsigned char* wsg = (__attribute__((address_space(1))) unsigned char*)p.ws; __attribute__((address_space(1))) float* outg = (__attribute__((address_space(1))) float*)p.out;
        asm volatile("" : "+v"(tid_)); asm volatile("" : "+s"(bid_)); asm volatile("" : "+s"(G_)); asm volatile("" : "+s"(wsg)); asm volatile("" : "+s"(outg));
        unsigned char* ws = (unsigned char*)wsg; float* out_ = (float*)outg;
        Frame F; F.lds = lds; F.tid = tid_; F.lane = F.tid & 63; F.wave = __builtin_amdgcn_readfirstlane(F.tid >> 6); F.G = G_; F.bid = bid_;
#pragma unroll
        for (int i = 0; i < 23; ++i) F.in[i] = (const float*)(const __attribute__((address_space(1))) float*)p.in[i];
        F.out = out_; F.ws = ws;
        bf16* xb = (bf16*)(ws + WS_XB); bf16* actb = (bf16*)(ws + WS_A); float* ssq = (float*)(ws + WS_SSQ); bf16* mix = (bf16*)(ws + WS_MIX);
        const int l = ph / PH_PER_LAYER, q = ph % PH_PER_LAYER;
#ifndef PH_MASK
#define PH_MASK 0x7ff
#endif
#define PHON(k) ((PH_MASK >> (k)) & 1)
        if (q == 0) { if (PHON(0)) prep_phase(F, l); }
        else if (PHON(1) && (q == 1 || q == 9)) {
            pg8::Gemm g{xb, (const bf16*)(ws + (q == 1 ? WS_W1 : WS_W3)), M, 2 * DFF, D};
            pg8::StaticOrder S; S.init(M, 2 * DFF, F.G, F.bid);
            pg8::EpiSwiGLU E{actb, ssq, DFF};
            pg8::gemm_phase<pg8::EpiSwiGLU, pg8::StaticOrder, true, true>(ring, g, S, E);
#if PROBE_FFNUP
            grid.sync(); pg8::gemm_phase<pg8::EpiSwiGLU, pg8::StaticOrder, true, true>(ring, g, S, E);
#endif
        } else if (PHON(2) && (q == 2 || q == 8 || q == 10)) {
            const bf16* A = q == 8 ? mix : actb; const bf16* Bt = (const bf16*)(ws + (q == 2 ? WS_W2 : q == 8 ? WS_WOUT : WS_W4)); const int K = q == 8 ? MIXK : DFF;
            pg8::Gemm g{A, Bt, M, D, K};
            pg8::StaticOrder S; S.init(M, D, F.G, F.bid);
            pg8::EpiResid E{(ph == NPHASE - 1) ? F.out : nullptr, xb, ssq, q == 8 ? 1.0f : 0.5f};
            pg8::gemm_phase<pg8::EpiResid, pg8::StaticOrder, true, true>(ring, g, S, E);
        } else if (PHON(3) && (q == 3 || q == 5)) {
            const int nj = q == 5 ? 3 : 1;
            for (int j = 0; j < nj; ++j) {
                pg8::Gemm g; pg8::EpiPlain E; int oid = F.bid;
                if (q == 3)      { g = pg8::Gemm{xb, (const bf16*)(ws + WS_WIN), M, INP - 256, D};                       E = pg8::EpiPlain{actb, INP, 0, ssq, nullptr, nullptr}; }
                else if (j == 0) { g = pg8::Gemm{(const bf16*)(ws + WS_CQN), (const bf16*)(ws + WS_WUQ), M, 768, 384};    E = pg8::EpiPlain{(bf16*)((unsigned char*)F.out + OUT_QF), 768, 0, nullptr, nullptr, nullptr}; }
                else if (j == 1) { g = pg8::Gemm{(const bf16*)(ws + WS_CKVN), (const bf16*)(ws + WS_WUKV), M, 1024, 256}; E = pg8::EpiPlain{(bf16*)((unsigned char*)F.out + OUT_KV), 1024, 0, nullptr, F.in[14] + l * 128, (PG8_LAS float*)((PG8_LAS unsigned char*)lds + 131072 + 1024)}; }
                else             { g = pg8::Gemm{xb, (const bf16*)(ws + WS_WIN) + (size_t)(INP - 256) * D, M, 256, D};   E = pg8::EpiPlain{actb, INP, INP - 256, ssq, nullptr, nullptr}; oid = (F.bid + F.G / 2) % F.G; }
                pg8::StaticOrder S; S.init(M, g.N, F.G, oid);
                pg8::gemm_phase<pg8::EpiPlain, pg8::StaticOrder, true, true>(ring, g, S, E);
            }
            if (PHON(5) && q == 5) { __syncthreads(); chunk_state_phase(F); }
        } else if (PHON(4) && q == 4) post1_phase(F, l);
        else if (PHON(6) && q == 6) { scan_phase(F); }
        else if (q == 7) { if (PHON(7)) { chunk_out_phase(F, l);
#if PROBE_CO
            xcd_barrier(xbar); chunk_out_phase(F, l);
#endif
            } __syncthreads();
#if PROBE_ATTN
            grid.sync(); attn_phase(F, l, true);
#endif
            if (PHON(8)) attn_phase(F, l); }
#if PROBE_REP
        if ((PROBE_REP >> q) & 1) { if (rep == 0) { rep = 1; grid.sync(); --ph; continue; } rep = 0; }
#endif
        if (ph + 1 < p.ph_hi) { if (ph == p.ph_lo + 7) grid.sync(); else xcd_barrier(xbar);     }
    }
}

extern "C" void kernel_launch(void* const* d_in, const int* in_sizes, int n_in, void* d_out, int out_size, void* d_ws, size_t ws_size, hipStream_t stream) {
    static int grid = 0;
    if (grid == 0) {
        if (n_in != 23 || in_sizes[0] != M * D || out_size != M * D || ws_size < WS_END) { fprintf(stderr, "kernel_launch: unexpected shapes (n_in %d, in0 %d, out %d, ws %zu; need ws >= %zu)\n", n_in, n_in > 0 ? in_sizes[0] : -1, out_size, ws_size, (size_t)WS_END); grid = -1; return; }
        int dev = 0, cus = 0, per_cu = 0;
        (void)hipGetDevice(&dev); (void)hipDeviceGetAttribute(&cus, hipDeviceAttributeMultiprocessorCount, dev);
        if (hipFuncSetAttribute((const void*)mega_fwd, hipFuncAttributeMaxDynamicSharedMemorySize, LDS_BYTES) != hipSuccess) fprintf(stderr, "kernel_launch: hipFuncSetAttribute failed\n");
        if (hipOccupancyMaxActiveBlocksPerMultiprocessor(&per_cu, (const void*)mega_fwd, NTHREADS, LDS_BYTES) != hipSuccess || per_cu < 1) { fprintf(stderr, "kernel_launch: occupancy query gave %d; using 1\n", per_cu); per_cu = 1; }
        (void)hipGetLastError();
        if (cus <= 0) cus = 256;
        grid = cus * per_cu;
    }
    if (grid < 0) return;
    Params p{};
    for (int i = 0; i < 23; ++i) p.in[i] = (const float*)d_in[i];
    p.out = (float*)d_out; p.ws = (unsigned char*)d_ws;
#if ONE_LAUNCH
    if (hipMemsetAsync((char*)d_ws + WS_CTL, 0, CTL_BYTES, stream) != hipSuccess) fprintf(stderr, "kernel_launch: hipMemsetAsync failed\n");
    p.ph_lo = 0; p.ph_hi = NPHASE;
    void* args[] = {&p};
    hipError_t e = hipLaunchCooperativeKernel((const void*)mega_fwd, dim3(grid), dim3(NTHREADS), args, LDS_BYTES, stream);
    if (e != hipSuccess) fprintf(stderr, "kernel_launch: cooperative launch failed: %s (grid %d)\n", hipGetErrorString(e), grid);
#else
    for (int ph = 0; ph < NPHASE; ++ph) { p.ph_lo = ph; p.ph_hi = ph + 1; hipLaunchKernelGGL(mega_fwd, dim3(grid), dim3(NTHREADS), LDS_BYTES, stream, p); }
#endif
}
```

```cpp
#include <hip/hip_runtime.h>
#include <hip/hip_cooperative_groups.h>
#include <hip/hip_bf16.h>
#include <cstdio>
#include <cstdint>
namespace cg = cooperative_groups;
namespace pg8 {
#define PG8_LAS __attribute__((address_space(3)))
typedef unsigned short bf16_t;
typedef short bf16x8 __attribute__((ext_vector_type(8)));
typedef float f32x4 __attribute__((ext_vector_type(4)));
typedef unsigned u32x4 __attribute__((ext_vector_type(4)));
constexpr int BM = 256, BK = 64, HALF = 128, HTB = HALF * BK * 2  , STAGE_BYTES = 8 * HTB, NXCD = 8, WGM = 8;

__host__ __device__ __forceinline__ int lds_byte(int r, int c) { const int st = (r >> 4) * 2 + (c >> 5), rr = r & 15, cc = c & 31, ob = rr * 64 + cc * 2; return st * 1024 + (ob ^ (((ob >> 9) & 1) << 5)); }
__host__ __device__ __forceinline__ void stage_rc(int b, int& R, int& C) { const int st = b / 1024, sb = b % 1024, swz = sb ^ (((sb >> 9) & 1) << 5); R = (st >> 1) * 16 + swz / 64; C = (st & 1) * 32 + (swz % 64) / 2; }
__host__ __device__ __forceinline__ int perm32(int rho) { const int n = rho >> 4, i = rho & 15; return 8 * (i >> 2) + 4 * n + (i & 3); }

struct Unit { int pm, pn; };
struct Gemm { const bf16_t* A; const bf16_t* Bt; int M, N, K; };

struct StaticOrder {
    int nM, nN, nwg, G, c;
    __host__ __device__ void init(int M, int N, int G_, int c_) { nM = M / BM; nN = N / BM; nwg = nM * nN; G = G_; c = c_; }
    __host__ __device__ bool next(int i, Unit& u) const {
        const long L = (long)i * G + c; if (L >= nwg) return false;
        int wgid = (int)L; { const int q = nwg / NXCD, r = nwg % NXCD, xcd = wgid % NXCD, off = wgid / NXCD; wgid = (xcd < r ? xcd * (q + 1) : r * (q + 1) + (xcd - r) * q) + off; }
        const int nig = WGM * nN, gid = wgid / nig, fm = gid * WGM, gsz = (nM - fm) < WGM ? (nM - fm) : WGM;
        u.pm = fm + ((wgid % nig) % gsz); u.pn = (wgid % nig) / gsz; return true;
    }
    __device__ __forceinline__ void a_ready(const Unit&) const {}
    __device__ __forceinline__ void done(const Unit&) const {}
};

__device__ __forceinline__ unsigned cvt_pk_bf16(float lo, float hi) { unsigned r; asm volatile("v_cvt_pk_bf16_f32 %0, %1, %2" : "=v"(r) : "v"(lo), "v"(hi)); return r; }
template <class Epi, class Sched, bool ALIGN_EPI = false, bool SP2 = false>
__device__ __forceinline__ void gemm_phase(PG8_LAS unsigned char* lds, const Gemm g, const Sched& S, const Epi& E) {
    int tid_l = threadIdx.x; asm volatile("" : "+v"(tid_l)); const int tid = tid_l, wid = __builtin_amdgcn_readfirstlane(tid >> 6), lane = tid & 63, wr = wid >> 2, wc = wid & 3, fr = lane & 15, fq = lane >> 4;
    const int K = g.K, nt = K / BK;
    unsigned voffA[2], voffB[2];
#pragma unroll
    for (int i = 0; i < 2; ++i) { int R, C; stage_rc(tid * 16 + i * 8192, R, C); const int Rb = Epi::PERM ? ((R & ~31) + perm32(R & 31)) : R;
        voffA[i] = (unsigned)(R * K + C) * 2u; voffB[i] = (unsigned)(Rb * K + C) * 2u; }
    const size_t kstep = (size_t)(BK * 2);
    const size_t hstep = (size_t)HALF * K * 2;
    const size_t tstep = 2 * hstep;
    const unsigned ldsw = (unsigned)wid * 1024u;
    const int aoff = lds_byte(wr * 64 + fr, fq * 8), boff = lds_byte(wc * 32 + fr, fq * 8);
#define PG8_SA(b, h) (((b) * 2 + (h)) * HTB)
#define PG8_SB(b, h) ((4 + (b) * 2 + (h)) * HTB)
#define PG8_STAGE(bufoff, gbase, voff) do { _Pragma("unroll") for (int _i = 0; _i < 2; ++_i) \
        __builtin_amdgcn_global_load_lds((const unsigned*)((const char*)(gbase) + (voff)[_i]), (PG8_LAS unsigned*)(lds + (bufoff) + ldsw + _i * 8192), 16, 0, 0); } while (0)
#define PG8_LDA(dst, b, h) do { _Pragma("unroll") for (int m = 0; m < 4; ++m) _Pragma("unroll") for (int k = 0; k < 2; ++k) dst[m][k] = *(const PG8_LAS bf16x8*)(lds + PG8_SA(b, h) + aoff + m * 2048 + k * 1024); } while (0)
#define PG8_LDB(dst, b, h) do { _Pragma("unroll") for (int n = 0; n < 2; ++n) _Pragma("unroll") for (int k = 0; k < 2; ++k) dst[n][k] = *(const PG8_LAS bf16x8*)(lds + PG8_SB(b, h) + boff + n * 2048 + k * 1024); } while (0)
#define PG8_MMA(ai, bj, At, Bt) do { __builtin_amdgcn_s_setprio(1); _Pragma("unroll") for (int m = 0; m < 4; ++m) _Pragma("unroll") for (int n = 0; n < 2; ++n) _Pragma("unroll") for (int k = 0; k < 2; ++k) \
        acc[ai][bj][m][n] = __builtin_amdgcn_mfma_f32_16x16x32_bf16(Bt[n][k], At[m][k], acc[ai][bj][m][n], 0, 0, 0); __builtin_amdgcn_s_setprio(0); } while (0)
#define PG8_WAIT_V(n) asm volatile("s_waitcnt vmcnt(" #n ")" ::: "memory")
#define PG8_WAIT_L(n) asm volatile("s_waitcnt lgkmcnt(" #n ")" ::: "memory")
#define PG8_BAR __builtin_amdgcn_s_barrier()
#define PG8_SCHED __builtin_amdgcn_sched_barrier(0)
    Unit cur, nxt; int ui = 0;
    if (!S.next(0, cur)) return;
    f32x4 acc[2][2][4][2];
#pragma unroll
    for (int a = 0; a < 2; ++a)
#pragma unroll
        for (int b = 0; b < 2; ++b)
#pragma unroll
            for (int m = 0; m < 4; ++m)
#pragma unroll
                for (int n = 0; n < 2; ++n) acc[a][b][m][n] = (f32x4){0.f, 0.f, 0.f, 0.f};
    bf16x8 At[4][2], B0[2][2], B1[2][2];
    const char* cA = (const char*)g.A + (size_t)cur.pm * tstep; const char* cB = (const char*)g.Bt + (size_t)cur.pn * tstep;
    S.a_ready(cur);
    if constexpr (SP2) {
        PG8_STAGE(PG8_SB(0, 0), cB, voffB); PG8_STAGE(PG8_SB(0, 1), cB + hstep, voffB); PG8_STAGE(PG8_SA(0, 0), cA, voffA); PG8_STAGE(PG8_SA(0, 1), cA + hstep, voffA);
        if (wr == 1) PG8_BAR;
        PG8_WAIT_V(2); PG8_BAR;
        PG8_STAGE(PG8_SB(1, 0), cB + kstep, voffB); PG8_STAGE(PG8_SA(1, 0), cA + kstep, voffA); PG8_STAGE(PG8_SB(1, 1), cB + hstep + kstep, voffB);
        PG8_WAIT_V(6); PG8_BAR;
    } else {
        PG8_STAGE(PG8_SB(0, 0), cB, voffB); PG8_STAGE(PG8_SA(0, 0), cA, voffA); PG8_STAGE(PG8_SB(0, 1), cB + hstep, voffB); PG8_STAGE(PG8_SA(0, 1), cA + hstep, voffA);
        if (wr == 1) PG8_BAR;
        PG8_WAIT_V(4); PG8_BAR;
        PG8_STAGE(PG8_SB(1, 0), cB + kstep, voffB); PG8_STAGE(PG8_SA(1, 0), cA + kstep, voffA); PG8_STAGE(PG8_SB(1, 1), cB + hstep + kstep, voffB);
        PG8_WAIT_V(6); PG8_BAR;
    }
    for (;;) {
        const bool has_next = S.next(ui + 1, nxt);
        const char* nA = has_next ? (const char*)g.A + (size_t)nxt.pm * tstep : cA; const char* nB = has_next ? (const char*)g.Bt + (size_t)nxt.pn * tstep : cB;
        for (int t = 0; t < nt; t += 2) {
            const bool last = (t == nt - 2);
            const char* a1 = cA + (size_t)(t + 1) * kstep;
            const char* a2 = last ? nA : cA + (size_t)(t + 2) * kstep; const char* b2 = last ? nB : cB + (size_t)(t + 2) * kstep;
            const char* a3 = a2 + kstep; const char* b3 = b2 + kstep;
            if (last && has_next) S.a_ready(nxt);
            if constexpr (SP2) {
            PG8_LDB(B0, 0, 0); PG8_LDB(B1, 0, 1); PG8_SCHED; PG8_LDA(At, 0, 0); PG8_STAGE(PG8_SA(1, 1), a1 + hstep, voffA);
            PG8_WAIT_V(8); PG8_WAIT_L(0); PG8_BAR; PG8_MMA(0, 0, At, B0); PG8_MMA(0, 1, At, B1); PG8_BAR; PG8_SCHED;
            PG8_LDA(At, 0, 1); PG8_STAGE(PG8_SB(0, 0), b2, voffB); PG8_STAGE(PG8_SB(0, 1), b2 + hstep, voffB); PG8_STAGE(PG8_SA(0, 0), a2, voffA);
            PG8_WAIT_V(8); PG8_WAIT_L(0); PG8_BAR; PG8_MMA(1, 0, At, B0); PG8_MMA(1, 1, At, B1); PG8_BAR; PG8_SCHED;
            PG8_LDB(B0, 1, 0); PG8_LDB(B1, 1, 1); PG8_SCHED; PG8_LDA(At, 1, 0); PG8_STAGE(PG8_SA(0, 1), a2 + hstep, voffA);
            PG8_WAIT_V(8); PG8_WAIT_L(0); PG8_BAR; PG8_MMA(0, 0, At, B0); PG8_MMA(0, 1, At, B1); PG8_BAR; PG8_SCHED;
            PG8_LDA(At, 1, 1); PG8_STAGE(PG8_SB(1, 0), b3, voffB); PG8_STAGE(PG8_SB(1, 1), b3 + hstep, voffB); PG8_STAGE(PG8_SA(1, 0), a3, voffA);
            PG8_WAIT_V(8); PG8_WAIT_L(0); PG8_BAR; PG8_MMA(1, 0, At, B0); PG8_MMA(1, 1, At, B1); PG8_BAR; PG8_SCHED;
            } else {
            PG8_LDB(B0, 0, 0); PG8_SCHED; PG8_LDA(At, 0, 0); PG8_STAGE(PG8_SA(1, 1), a1 + hstep, voffA);
            PG8_WAIT_L(8); PG8_BAR; PG8_WAIT_L(0); PG8_MMA(0, 0, At, B0); PG8_BAR; PG8_SCHED;
            PG8_LDB(B1, 0, 1); PG8_STAGE(PG8_SB(0, 0), b2, voffB);
            PG8_BAR; PG8_WAIT_L(0); PG8_MMA(0, 1, At, B1); PG8_BAR;
            PG8_LDA(At, 0, 1); PG8_STAGE(PG8_SA(0, 0), a2, voffA);
            PG8_BAR; PG8_WAIT_L(0); PG8_MMA(1, 0, At, B0); PG8_BAR; PG8_SCHED;
            PG8_STAGE(PG8_SB(0, 1), b2 + hstep, voffB);
            PG8_WAIT_V(6); PG8_BAR; PG8_MMA(1, 1, At, B1); PG8_BAR;
            PG8_LDB(B0, 1, 0); PG8_SCHED; PG8_LDA(At, 1, 0); PG8_STAGE(PG8_SA(0, 1), a2 + hstep, voffA);
            PG8_WAIT_L(8); PG8_BAR; PG8_WAIT_L(0); PG8_MMA(0, 0, At, B0); PG8_BAR; PG8_SCHED;
            PG8_LDB(B1, 1, 1); PG8_STAGE(PG8_SB(1, 0), b3, voffB);
            PG8_BAR; PG8_WAIT_L(0); PG8_MMA(0, 1, At, B1); PG8_BAR;
            PG8_LDA(At, 1, 1); PG8_STAGE(PG8_SA(1, 0), a3, voffA);
            PG8_BAR; PG8_WAIT_L(0); PG8_MMA(1, 0, At, B0); PG8_BAR; PG8_SCHED;
            PG8_STAGE(PG8_SB(1, 1), b3 + hstep, voffB);
            PG8_WAIT_V(6); PG8_BAR; PG8_MMA(1, 1, At, B1); PG8_BAR;
            }
        }
        if constexpr (ALIGN_EPI) { if (wr == 0) PG8_BAR; }
        if constexpr (!Epi::AFTER_DRAIN) { E(acc, cur, wr, wc, fr, fq); S.done(cur); }
        if (!has_next) break;
#pragma unroll
        for (int a = 0; a < 2; ++a)
#pragma unroll
            for (int b = 0; b < 2; ++b)
#pragma unroll
                for (int m = 0; m < 4; ++m)
#pragma unroll
                    for (int n = 0; n < 2; ++n) acc[a][b][m][n] = (f32x4){0.f, 0.f, 0.f, 0.f};
        cur = nxt; cA = nA; cB = nB; ++ui;
        if constexpr (ALIGN_EPI) { if (wr == 1) PG8_BAR; }
    }
    PG8_WAIT_V(0);
    if constexpr (!ALIGN_EPI) { if (wr == 0) PG8_BAR; }
    PG8_BAR;
    if constexpr (Epi::AFTER_DRAIN) { E.fused(acc, cur, wr, wc, fr, fq, lds, wid, lane); S.done(cur); }
#undef PG8_SA
#undef PG8_SB
#undef PG8_STAGE
#undef PG8_LDA
#undef PG8_LDB
#undef PG8_MMA
#undef PG8_WAIT_V
#undef PG8_WAIT_L
#undef PG8_BAR
#undef PG8_SCHED
}
}
namespace pg8 {
__device__ __forceinline__ void load_rstd(const float* ssq, const Unit& u, int wr, int fr, int fq, float (&rs)[2][4]) {
#pragma unroll
    for (int ai = 0; ai < 2; ++ai)
#pragma unroll
        for (int m = 0; m < 4; ++m) {
            const int row = u.pm * BM + ai * HALF + wr * 64 + m * 16 + fr;
            const f32x4 v = *(const f32x4*)(ssq + (size_t)row * 16 + 4 * fq);
            float s = (v[0] + v[1]) + (v[2] + v[3]);
            s += __shfl_xor(s, 16); s += __shfl_xor(s, 32);
            rs[ai][m] = rsqrtf(s * (1.0f / 1024.0f) + 1e-6f);
        }
}
__device__ __forceinline__ float silu_f(float g) { return g * __builtin_amdgcn_rcpf(1.0f + __expf(-g)); }
struct EpiSwiGLU {
    static constexpr bool PERM = true, AFTER_DRAIN = false;
    bf16_t* O; const float* ssq; int ldo;
    __device__ __forceinline__ void operator()(const f32x4 (&acc)[2][2][4][2], const Unit& u, int wr, int wc, int fr, int fq) const {
        float rs[2][4]; load_rstd(ssq, u, wr, fr, fq, rs);
        const int col0 = u.pn * 128 + wc * 32 + 8 * fq;
#pragma unroll
        for (int ai = 0; ai < 2; ++ai)
#pragma unroll
            for (int m = 0; m < 4; ++m) {
                const int row = u.pm * BM + ai * HALF + wr * 64 + m * 16 + fr; const float r = rs[ai][m];
                u32x4 w;
#pragma unroll
                for (int n = 0; n < 2; ++n) {
                    const f32x4 g = acc[ai][0][m][n] * r, uu = acc[ai][1][m][n] * r;
                    const float h0 = silu_f(g[0]) * uu[0], h1 = silu_f(g[1]) * uu[1], h2 = silu_f(g[2]) * uu[2], h3 = silu_f(g[3]) * uu[3];
                    w[2 * n] = cvt_pk_bf16(h0, h1); w[2 * n + 1] = cvt_pk_bf16(h2, h3);
                }
                *(u32x4*)(O + (size_t)row * ldo + col0) = w;
            }
    }
};
struct EpiResid {
    static constexpr bool PERM = true, AFTER_DRAIN = false;
    float* out_final; bf16_t* xb; float* ssq; float alpha;
    __device__ __forceinline__ void operator()(const f32x4 (&acc)[2][2][4][2], const Unit& u, int wr, int wc, int fr, int fq) const {
        const int col0 = u.pn * BM + wc * 32 + 8 * fq;
#pragma unroll
        for (int ai = 0; ai < 2; ++ai)
#pragma unroll
            for (int m = 0; m < 4; ++m) {
                const int row = u.pm * BM + ai * HALF + wr * 64 + m * 16 + fr; float ss = 0.f;
#pragma unroll
                for (int bj = 0; bj < 2; ++bj) {
                    const size_t off = (size_t)row * 1024 + col0 + bj * HALF;
                    const u32x4 xo = *(const u32x4*)(xb + off);
                    f32x4 x0, x1;
                    x0[0] = __builtin_bit_cast(float, xo[0] << 16); x0[1] = __builtin_bit_cast(float, xo[0] & 0xffff0000u); x0[2] = __builtin_bit_cast(float, xo[1] << 16); x0[3] = __builtin_bit_cast(float, xo[1] & 0xffff0000u);
                    x1[0] = __builtin_bit_cast(float, xo[2] << 16); x1[1] = __builtin_bit_cast(float, xo[2] & 0xffff0000u); x1[2] = __builtin_bit_cast(float, xo[3] << 16); x1[3] = __builtin_bit_cast(float, xo[3] & 0xffff0000u);
                    x0 += acc[ai][bj][m][0] * alpha; x1 += acc[ai][bj][m][1] * alpha;
                    if (out_final) { *(f32x4*)(out_final + off) = x0; *(f32x4*)(out_final + off + 4) = x1; }
                    else {
                        u32x4 w; w[0] = cvt_pk_bf16(x0[0], x0[1]); w[1] = cvt_pk_bf16(x0[2], x0[3]); w[2] = cvt_pk_bf16(x1[0], x1[1]); w[3] = cvt_pk_bf16(x1[2], x1[3]);
                        *(u32x4*)(xb + off) = w;
                        ss += (x0[0] * x0[0] + x0[1] * x0[1]) + (x0[2] * x0[2] + x0[3] * x0[3]) + (x1[0] * x1[0] + x1[1] * x1[1]) + (x1[2] * x1[2] + x1[3] * x1[3]);
                    }
                }
                if (!out_final) { ss += __shfl_xor(ss, 16); ss += __shfl_xor(ss, 32);
                    if (fq == 0) ssq[(size_t)row * 16 + u.pn * 4 + wc] = ss; }
            }
    }
};
struct EpiPlain {
    static constexpr bool PERM = true, AFTER_DRAIN = false;
    bf16_t* O; int ldo; int col_off; const float* ssq;
    const float* kn_gain; PG8_LAS float* red;
    __device__ __forceinline__ void operator()(const f32x4 (&acc)[2][2][4][2], const Unit& u, int wr, int wc, int fr, int fq) const {
        float rs[2][4];
        if (ssq) load_rstd(ssq, u, wr, fr, fq, rs);
        if (kn_gain) {
#pragma unroll
            for (int ai = 0; ai < 2; ++ai)
#pragma unroll
                for (int m = 0; m < 4; ++m) { const f32x4 a = acc[ai][0][m][0], b = acc[ai][0][m][1];
                    float ss = (a[0] * a[0] + a[1] * a[1]) + (a[2] * a[2] + a[3] * a[3]) + (b[0] * b[0] + b[1] * b[1]) + (b[2] * b[2] + b[3] * b[3]);
                    ss += __shfl_xor(ss, 16); ss += __shfl_xor(ss, 32);
                    if (fq == 0) red[(ai * HALF + wr * 64 + m * 16 + fr) * 4 + wc] = ss; }
            asm volatile("s_waitcnt lgkmcnt(0)\n\ts_barrier" ::: "memory");
#pragma unroll
            for (int ai = 0; ai < 2; ++ai)
#pragma unroll
                for (int m = 0; m < 4; ++m) { const f32x4 p = *(const PG8_LAS f32x4*)(red + (ai * HALF + wr * 64 + m * 16 + fr) * 4);
                    rs[ai][m] = rsqrtf(((p[0] + p[1]) + (p[2] + p[3])) * (1.0f / 128.0f) + 1e-6f); }
        }
        const int col0 = col_off + u.pn * BM + wc * 32 + 8 * fq;
#pragma unroll
        for (int ai = 0; ai < 2; ++ai)
#pragma unroll
            for (int m = 0; m < 4; ++m) {
                const int row = u.pm * BM + ai * HALF + wr * 64 + m * 16 + fr; const float r = (ssq || kn_gain) ? rs[ai][m] : 1.0f;
#pragma unroll
                for (int bj = 0; bj < 2; ++bj) {
                    f32x4 v0 = acc[ai][bj][m][0], v1 = acc[ai][bj][m][1];
                    if (!kn_gain || bj == 0) { v0 = v0 * r; v1 = v1 * r; }
                    u32x4 w; w[0] = cvt_pk_bf16(v0[0], v0[1]); w[1] = cvt_pk_bf16(v0[2], v0[3]); w[2] = cvt_pk_bf16(v1[0], v1[1]); w[3] = cvt_pk_bf16(v1[2], v1[3]);
                    *(u32x4*)(O + (size_t)row * ldo + col0 + bj * HALF) = w;
                }
            }
    }
};
}
namespace att {
typedef unsigned short bf16_t;
typedef short bf16x8 __attribute__((ext_vector_type(8)));
typedef short s16x4 __attribute__((ext_vector_type(4)));
typedef float f32x16 __attribute__((ext_vector_type(16)));
typedef float f32x4 __attribute__((ext_vector_type(4)));
typedef unsigned u32x4 __attribute__((ext_vector_type(4)));
constexpr int DQK = 192, DV = 128, SEQ = 16384;
constexpr int LDQ = 768, LDK = 1024, LDKR = 64, LDV = 1024, LDO = 1024;
constexpr float SCALE = 0.07216878364870322f;
constexpr float THR = 8.f;
constexpr int NW = 8, QBLK = 32, KVBLK = 64, QB = NW * QBLK;
constexpr int SHM_V = KVBLK * DV * 2, SHM_K = KVBLK * DQK * 2;
constexpr int LDS_BYTES = 2 * SHM_V + 2 * SHM_K + NW * 64 * 4;
#define KSWZ(row, colB) ((row) * 384 + ((colB) ^ ((((row) >> 1) & 7) << 4)))
#define SBAR() __builtin_amdgcn_sched_barrier(0)
__device__ __forceinline__ int v_st(int k, int c) { const int kk = (k & ~0xC) | ((k & 4) << 1) | ((k & 8) >> 1); return ((kk >> 3) * 4 + (c >> 5)) * 512 + ((kk & 7) * 32 + (c & 31)) * 2; }
__device__ __forceinline__ int v_rd_base(int lane) { return ((lane & 3) << 3) | (((lane >> 2) & 3) << 6) | (((lane >> 4) & 1) << 5) | (((lane >> 5) & 1) << 8); }
constexpr int v_rd_off(int d0, int ks, int half) { return d0 * 512 + ks * 4096 + half * 2048; }
__device__ __forceinline__ int crow(int r, int hi) { return (r & 3) + 8 * (r >> 2) + 4 * hi; }
__device__ __forceinline__ unsigned cvtpk(float lo, float hi) { unsigned r; asm volatile("v_cvt_pk_bf16_f32 %0, %1, %2" : "=v"(r) : "v"(lo), "v"(hi)); return r; }
__device__ __forceinline__ bf16x8 load8(const bf16_t* p) { return *reinterpret_cast<const bf16x8*>(p); }
__device__ __forceinline__ void mask_tile(f32x16& p0, f32x16& p1, int dq) {
    const float NEG = -__builtin_inff();
#pragma unroll
    for (int r = 0; r < 16; ++r) {
        const int c = (r & 3) + 8 * (r >> 2);
        if (dq - c < 0) p0[r] = NEG;
        if (dq - c - 32 < 0) p1[r] = NEG;
    }
}
__device__ __forceinline__ void partialSM(f32x16& p0, f32x16& p1, float& m_reg, float& mn, float& alpha) {
    float pmax = p0[0];
#pragma unroll
    for (int r = 1; r < 16; ++r) pmax = fmaxf(pmax, p0[r]);
#pragma unroll
    for (int r = 0; r < 16; ++r) pmax = fmaxf(pmax, p1[r]);
    { auto rr = __builtin_amdgcn_permlane32_swap(__float_as_uint(pmax), __float_as_uint(pmax), false, false);
      pmax = fmaxf(__uint_as_float(rr[0]), __uint_as_float(rr[1])); }
    constexpr float C2 = 1.4426950408889634f * SCALE;
    if (__builtin_expect(__all((pmax - m_reg) * SCALE <= THR), 1)) { mn = m_reg; alpha = 1.f; }
    else { mn = fmaxf(m_reg, pmax); alpha = __builtin_amdgcn_exp2f((m_reg - mn) * C2); m_reg = mn; }
    const float mnL = -mn * C2;
#pragma unroll
    for (int r = 0; r < 16; ++r) p0[r] = fmaf(p0[r], C2, mnL);
#pragma unroll
    for (int r = 0; r < 16; ++r) p1[r] = fmaf(p1[r], C2, mnL);
#pragma unroll
    for (int r = 0; r < 16; ++r) p0[r] = __builtin_amdgcn_exp2f(p0[r]);
}
__device__ __forceinline__ void finishSM(f32x16& p0, f32x16& p1, float alpha, float& l_reg, bf16x8& pa0, bf16x8& pa1, bf16x8& pa2, bf16x8& pa3) {
#pragma unroll
    for (int r = 0; r < 16; ++r) p1[r] = __builtin_amdgcn_exp2f(p1[r]);
    float ps = 0;
#pragma unroll
    for (int r = 0; r < 16; ++r) ps += p0[r];
#pragma unroll
    for (int r = 0; r < 16; ++r) ps += p1[r];
    { auto rr = __builtin_amdgcn_permlane32_swap(__float_as_uint(ps), __float_as_uint(ps), false, false);
      ps = __uint_as_float(rr[0]) + __uint_as_float(rr[1]); }
    l_reg = l_reg * alpha + ps;
#define PK4(P, B_, OUT) do { unsigned a0 = cvtpk(P[B_+0], P[B_+1]), a1 = cvtpk(P[B_+2], P[B_+3]);                          \
        unsigned b0 = cvtpk(P[B_+4], P[B_+5]), b1 = cvtpk(P[B_+6], P[B_+7]);                                             \
        auto r0 = __builtin_amdgcn_permlane32_swap(a0, b0, false, false); auto r1 = __builtin_amdgcn_permlane32_swap(a1, b1, false, false); \
        u32x4 w = {r0[0], r1[0], r0[1], r1[1]}; OUT = *reinterpret_cast<bf16x8*>(&w); } while (0)
    PK4(p0, 0, pa0); PK4(p0, 8, pa1); PK4(p1, 0, pa2); PK4(p1, 8, pa3);
#undef PK4
}
__device__ __forceinline__ void staticSM(f32x16& p0, f32x16& p1, float mB) {
    constexpr float C2 = 1.4426950408889634f * SCALE;
#pragma unroll
    for (int r = 0; r < 16; ++r) p0[r] = __builtin_amdgcn_exp2f(fmaf(p0[r], C2, -mB));
}
template <int KB>
__device__ __forceinline__ void qkt(f32x16& p0, f32x16& p1, const char* K_lds, int r32, int hi, const bf16x8* qr) {
    p0 = f32x16{}; p1 = f32x16{};
    const char* kb[4];
#pragma unroll
    for (int dd = 0; dd < 4; ++dd) kb[dd] = K_lds + KB * SHM_K + KSWZ(r32, (dd * 16 + hi * 8) * 2);
    bf16x8 fa[3], fb[3];
#pragma unroll
    for (int d0 = 0; d0 < 2; ++d0) { const char* a = kb[d0 & 3] + (d0 >> 2) * 128; fa[d0] = *reinterpret_cast<const bf16x8*>(a); fb[d0] = *reinterpret_cast<const bf16x8*>(a + 32 * 384); }
    __builtin_amdgcn_sched_barrier(0);
#pragma unroll
    for (int d0 = 0; d0 < 12; ++d0) {
        if (d0 + 2 < 12) { const char* a = kb[(d0 + 2) & 3] + ((d0 + 2) >> 2) * 128; fa[(d0 + 2) % 3] = *reinterpret_cast<const bf16x8*>(a); fb[(d0 + 2) % 3] = *reinterpret_cast<const bf16x8*>(a + 32 * 384); }
        p0 = __builtin_amdgcn_mfma_f32_32x32x16_bf16(fa[d0 % 3], qr[d0], p0, 0, 0, 0);
        p1 = __builtin_amdgcn_mfma_f32_32x32x16_bf16(fb[d0 % 3], qr[d0], p1, 0, 0, 0);
        __builtin_amdgcn_sched_barrier(0);
    }
}
template <int VB>
__device__ __forceinline__ void pv_tile(f32x16* o, int vb0, bf16x8 pa0, bf16x8 pa1, bf16x8 pa2, bf16x8 pa3) {
#define TRRD(dst, off) asm volatile("ds_read_b64_tr_b16 %0, %1 offset:%2" : "=&v"(dst) : "v"(vb0), "i"(off) : "memory")
#define PV_D0(d0) do { s16x4 l0, l1, l2, l3, h0, h1, h2, h3; constexpr int b_ = VB * SHM_V + v_rd_off(d0, 0, 0);    \
        TRRD(l0, b_); TRRD(h0, b_ + 2048); TRRD(l1, b_ + 4096); TRRD(h1, b_ + 6144); TRRD(l2, b_ + 8192); TRRD(h2, b_ + 10240); TRRD(l3, b_ + 12288); TRRD(h3, b_ + 14336); \
        asm volatile("s_waitcnt lgkmcnt(0)" ::: "memory"); SBAR();                                                   \
        o[d0] = __builtin_amdgcn_mfma_f32_32x32x16_bf16(pa0, (bf16x8){l0[0], l0[1], l0[2], l0[3], h0[0], h0[1], h0[2], h0[3]}, o[d0], 0, 0, 0);   \
        o[d0] = __builtin_amdgcn_mfma_f32_32x32x16_bf16(pa1, (bf16x8){l1[0], l1[1], l1[2], l1[3], h1[0], h1[1], h1[2], h1[3]}, o[d0], 0, 0, 0);   \
        o[d0] = __builtin_amdgcn_mfma_f32_32x32x16_bf16(pa2, (bf16x8){l2[0], l2[1], l2[2], l2[3], h2[0], h2[1], h2[2], h2[3]}, o[d0], 0, 0, 0);   \
        o[d0] = __builtin_amdgcn_mfma_f32_32x32x16_bf16(pa3, (bf16x8){l3[0], l3[1], l3[2], l3[3], h3[0], h3[1], h3[2], h3[3]}, o[d0], 0, 0, 0); } while (0)
    PV_D0(0); PV_D0(1); PV_D0(2); PV_D0(3);
#undef PV_D0
#undef TRRD
}
template <int VB>
__device__ __forceinline__ void pv_tile_pipe(f32x16* o, int vb0, bf16x8 pa0, bf16x8 pa1, bf16x8 pa2, bf16x8 pa3) {
#define TRRD(dst, off) asm volatile("ds_read_b64_tr_b16 %0, %1 offset:%2" : "=&v"(dst) : "v"(vb0), "i"(off) : "memory")
#define PV_RD(S, d0) do { constexpr int b_ = VB * SHM_V + v_rd_off(d0, 0, 0); TRRD(S[0], b_); TRRD(S[1], b_ + 2048); TRRD(S[2], b_ + 4096); TRRD(S[3], b_ + 6144); TRRD(S[4], b_ + 8192); TRRD(S[5], b_ + 10240); TRRD(S[6], b_ + 12288); TRRD(S[7], b_ + 14336); } while (0)
#define PV_MM(S, d0) do {                                                                                                                   \
        o[d0] = __builtin_amdgcn_mfma_f32_32x32x16_bf16(pa0, (bf16x8){S[0][0], S[0][1], S[0][2], S[0][3], S[1][0], S[1][1], S[1][2], S[1][3]}, o[d0], 0, 0, 0);   \
        o[d0] = __builtin_amdgcn_mfma_f32_32x32x16_bf16(pa1, (bf16x8){S[2][0], S[2][1], S[2][2], S[2][3], S[3][0], S[3][1], S[3][2], S[3][3]}, o[d0], 0, 0, 0);   \
        o[d0] = __builtin_amdgcn_mfma_f32_32x32x16_bf16(pa2, (bf16x8){S[4][0], S[4][1], S[4][2], S[4][3], S[5][0], S[5][1], S[5][2], S[5][3]}, o[d0], 0, 0, 0);   \
        o[d0] = __builtin_amdgcn_mfma_f32_32x32x16_bf16(pa3, (bf16x8){S[6][0], S[6][1], S[6][2], S[6][3], S[7][0], S[7][1], S[7][2], S[7][3]}, o[d0], 0, 0, 0); } while (0)
    s16x4 A[8], B[8];
    PV_RD(A, 0); asm volatile("s_waitcnt lgkmcnt(0)" ::: "memory"); SBAR();
    PV_RD(B, 1); SBAR(); PV_MM(A, 0); asm volatile("s_waitcnt lgkmcnt(0)" ::: "memory"); SBAR();
    PV_RD(A, 2); SBAR(); PV_MM(B, 1); asm volatile("s_waitcnt lgkmcnt(0)" ::: "memory"); SBAR();
    PV_RD(B, 3); SBAR(); PV_MM(A, 2); asm volatile("s_waitcnt lgkmcnt(0)" ::: "memory"); SBAR();
    PV_MM(B, 3);
#undef PV_RD
#undef PV_MM
#undef TRRD
}
struct QNorm { const float* gqn; const float* gkn; const float* gqr; const float* rc; const float* rsn; };
__device__ __forceinline__ float bfbits2f(short v) { return __builtin_bit_cast(float, (unsigned)(unsigned short)v << 16); }
__device__ __forceinline__ short f2bfbits(float f) { unsigned u = __builtin_bit_cast(unsigned, f); return (short)((u + 0x7fffu + ((u >> 16) & 1u)) >> 16); }
__device__ __forceinline__ void q_postproc(bf16x8* qr, const QNorm& qn, int tok, int hi) {
    float s1 = 0.f, s2 = 0.f;
#pragma unroll
    for (int d0 = 0; d0 < 12; ++d0)
#pragma unroll
        for (int j = 0; j < 8; ++j) { const float v = bfbits2f(qr[d0][j]); if (d0 < 8) s1 += v * v; else s2 += v * v; }
    { auto rr = __builtin_amdgcn_permlane32_swap(__float_as_uint(s1), __float_as_uint(s1), false, false); s1 = __uint_as_float(rr[0]) + __uint_as_float(rr[1]); }
    { auto rr = __builtin_amdgcn_permlane32_swap(__float_as_uint(s2), __float_as_uint(s2), false, false); s2 = __uint_as_float(rr[0]) + __uint_as_float(rr[1]); }
    const float r1 = rsqrtf(s1 * (1.0f / 128.0f) + 1e-6f), r2 = rsqrtf(s2 * (1.0f / 64.0f) + 1e-6f);
#pragma unroll
    for (int d0 = 0; d0 < 8; ++d0) { const f32x4 g0 = *(const f32x4*)(qn.gqn + 16 * d0 + 8 * hi) * *(const f32x4*)(qn.gkn + 16 * d0 + 8 * hi), g1 = *(const f32x4*)(qn.gqn + 16 * d0 + 8 * hi + 4) * *(const f32x4*)(qn.gkn + 16 * d0 + 8 * hi + 4);
#pragma unroll
        for (int j = 0; j < 8; ++j) qr[d0][j] = f2bfbits(bfbits2f(qr[d0][j]) * r1 * (j < 4 ? g0[j] : g1[j - 4]));
        if (d0 & 1) asm volatile("" ::: "memory"); }
#pragma unroll
    for (int d0 = 8; d0 < 10; ++d0) { const int i0 = 16 * (d0 - 8) + 8 * hi;
        const f32x4 ga0 = *(const f32x4*)(qn.gqr + i0), ga1 = *(const f32x4*)(qn.gqr + i0 + 4), gb0 = *(const f32x4*)(qn.gqr + 32 + i0), gb1 = *(const f32x4*)(qn.gqr + 32 + i0 + 4);
        const f32x4 c0 = *(const f32x4*)(qn.rc + (size_t)tok * 32 + i0), c1 = *(const f32x4*)(qn.rc + (size_t)tok * 32 + i0 + 4), n0 = *(const f32x4*)(qn.rsn + (size_t)tok * 32 + i0), n1 = *(const f32x4*)(qn.rsn + (size_t)tok * 32 + i0 + 4);
#pragma unroll
        for (int j = 0; j < 8; ++j) { const float x1 = bfbits2f(qr[d0][j]) * r2 * (j < 4 ? ga0[j] : ga1[j - 4]), x2 = bfbits2f(qr[d0 + 2][j]) * r2 * (j < 4 ? gb0[j] : gb1[j - 4]);
            const float c = j < 4 ? c0[j] : c1[j - 4], sn = j < 4 ? n0[j] : n1[j - 4];
            qr[d0][j] = f2bfbits(x1 * c - x2 * sn); qr[d0 + 2][j] = f2bfbits(x1 * sn + x2 * c); } }
}
struct BlockRef { const bf16_t* Q; const bf16_t* K; const bf16_t* KR; bf16_t* O; int P0; int tok0; };
#define VMW() asm volatile("s_waitcnt vmcnt(0)" ::: "memory")
struct StReg { bf16x8 v0, v1, k0, k1, k2; };
#define SLOAD_H(S_, k0_) do { S_.v0 = load8(Vh + (size_t)((k0_) + sr) * LDV + sc); S_.v1 = load8(Vh + (size_t)((k0_) + 32 + sr) * LDV + sc);   \
        S_.k0 = load8(Kh + (size_t)((k0_) + kr0) * LDK + kc0); S_.k1 = load8(Kh + (size_t)((k0_) + kr1) * LDK + kc1); S_.k2 = load8(KRh + (size_t)((k0_) + kr2) * LDKR + (kc2 - 128)); } while (0)
#define SWRITE_H(S_, bf) do { *(bf16x8*)(V_lds + (bf) * SHM_V + vst0) = S_.v0; *(bf16x8*)(V_lds + (bf) * SHM_V + vst1) = S_.v1;            \
        *(bf16x8*)(K_lds + (bf) * SHM_K + kws0) = S_.k0; *(bf16x8*)(K_lds + (bf) * SHM_K + kws1) = S_.k1; *(bf16x8*)(K_lds + (bf) * SHM_K + kws2) = S_.k2; } while (0)
template <bool STATIC>
__device__ __forceinline__ void attn_block(const BlockRef& cur, char* lds, float mB, const QNorm& qn) {
    int tid_l = threadIdx.x; asm volatile("" : "+v"(tid_l)); const int tid = tid_l, wid = __builtin_amdgcn_readfirstlane(tid >> 6), lane = tid & 63, r32 = lane & 31, hi = lane >> 5;
    const int NT = (cur.P0 + QB) / KVBLK;
    const int qlo = cur.P0 + wid * QBLK, qm = qlo + r32 - 4 * hi;
    char* V_lds = lds; char* K_lds = lds + 2 * SHM_V;
    float* ws = (float*)(lds + 2 * SHM_V + 2 * SHM_K) + wid * 64; float* li_l = ws, * al_l = ws + 32;
    float m_reg = -1e30f, l_reg = 0; f32x16 o[4] = {};
    const int sr = tid >> 4, sc = (tid & 15) * 8;
    const int kr0 = tid >> 4, kc0 = (tid & 15) * 8, kr1 = kr0 + 32, kc1 = kc0, kr2 = tid >> 3, kc2 = 128 + (tid & 7) * 8;
    const int kws0 = KSWZ(kr0, kc0 * 2), kws1 = KSWZ(kr1, kc1 * 2), kws2 = KSWZ(kr2, kc2 * 2);
    const int vst0 = v_st(sr, sc), vst1 = v_st(32 + sr, sc);
    const int vb0 = (int)(uintptr_t)V_lds + v_rd_base(lane);
    const bf16_t* Kh = cur.K; const bf16_t* KRh = cur.KR; const bf16_t* Vh = cur.K + 128;
    StReg sA;
    bf16x8 qr[12];
#pragma unroll
    for (int d0 = 0; d0 < 12; ++d0) qr[d0] = load8(cur.Q + (size_t)(wid * QBLK + r32) * LDQ + d0 * 16 + hi * 8);
    SLOAD_H(sA, 0); VMW(); SWRITE_H(sA, 0);
    q_postproc(qr, qn, cur.tok0 + wid * QBLK + r32, hi);
    SLOAD_H(sA, KVBLK);
    asm volatile("s_waitcnt lgkmcnt(0)\n\ts_barrier" ::: "memory");
#define RESC(a) do { if (__any((a) < 1.f)) { if (hi == 0) al_l[r32] = (a); asm volatile("s_waitcnt lgkmcnt(0)" ::: "memory");              \
                     _Pragma("unroll") for (int d_ = 0; d_ < 4; ++d_) _Pragma("unroll") for (int r = 0; r < 16; ++r) o[d_][r] *= al_l[crow(r, hi)]; } } while (0)
#define KBASE(t) ((t) * KVBLK)
#define MASKT(P0_, P1_, t) do { const int kb_ = KBASE(t); if (kb_ + KVBLK - 1 > qlo) mask_tile(P0_, P1_, qm - kb_); } while (0)
    f32x16 p0, p1; float mn, al; bf16x8 pa0, pa1, pa2, pa3;
#define STEP(t, BUF, SN, SW) do {                                                                                             \
        SWRITE_H(sA, 1 - BUF);     \
        { const int tn_ = (t) + 2 < NT ? (t) + 2 : NT - 1; SLOAD_H(sA, KBASE(tn_)); }     \
        SBAR(); qkt<BUF>(p0, p1, K_lds, r32, hi, qr);                                                                         \
        MASKT(p0, p1, (t));                                                                                                   \
        if (STATIC) { staticSM(p0, p1, mB); _Pragma("unroll") for (int r_ = 0; r_ < 16; ++r_) p1[r_] = fmaf(p1[r_], 1.4426950408889634f * SCALE, -mB); finishSM(p0, p1, 1.0f, l_reg, pa0, pa1, pa2, pa3); } \
        else { partialSM(p0, p1, m_reg, mn, al); finishSM(p0, p1, al, l_reg, pa0, pa1, pa2, pa3); RESC(al); } SBAR();       \
        if (STATIC) pv_tile_pipe<BUF>(o, vb0, pa0, pa1, pa2, pa3); else pv_tile<BUF>(o, vb0, pa0, pa1, pa2, pa3);             \
        asm volatile("s_waitcnt lgkmcnt(0)\n\ts_barrier" ::: "memory"); } while (0)
    for (int t = 0; t < NT; t += 2) { STEP(t, 0, sA, sA); STEP(t + 1, 1, sA, sA); }
    if (hi == 0) li_l[r32] = l_reg; asm volatile("s_waitcnt lgkmcnt(0)" ::: "memory");
    float rli[16];
#pragma unroll
    for (int r = 0; r < 16; ++r) rli[r] = __builtin_amdgcn_rcpf(li_l[crow(r, hi)]);
    bf16_t* Ow = cur.O + (size_t)(wid * QBLK) * LDO;
#pragma unroll
    for (int r = 0; r < 16; ++r) { const int orow = crow(r, hi);
#pragma unroll
        for (int d0 = 0; d0 < 4; ++d0) { const float v = o[d0][r] * rli[r];
            const float vn = __shfl_xor(v, 1);
            if ((r32 & 1) == 0) *(unsigned*)(Ow + (size_t)orow * LDO + d0 * 32 + r32) = cvtpk(v, vn); } }
    __syncthreads();
#undef RESC
#undef KBASE
#undef MASKT
#undef STEP
}
#undef VMW
#undef SLOAD_H
#undef SWRITE_H
#undef SBAR
}
#define LAS __attribute__((address_space(3)))
typedef unsigned short bf16;
typedef float f32x4 __attribute__((ext_vector_type(4)));
typedef float f32x2 __attribute__((ext_vector_type(2)));
typedef float f32x16 __attribute__((ext_vector_type(16)));
typedef unsigned u32x4 __attribute__((ext_vector_type(4)));
typedef unsigned u32x2 __attribute__((ext_vector_type(2)));
typedef short bf16x8 __attribute__((ext_vector_type(8)));
typedef short s16x4 __attribute__((ext_vector_type(4)));
#ifndef PROBE_ATTN
#define PROBE_ATTN 0
#endif
#ifndef PROBE_FFNUP
#define PROBE_FFNUP 0
#endif
#ifndef PROBE_REP
#define PROBE_REP 0
#endif
#ifndef PROBE_SYNC
#define PROBE_SYNC 0
#endif
#ifndef PROBE_CO
#define PROBE_CO 0
#endif
#ifndef ONE_LAUNCH
#define ONE_LAUNCH 1
#endif
constexpr int NB = 2, SEQ = 16384, M = NB * SEQ, D = 1024, DFF = 2816, INC = 2768, INP = 2816, MIXK = 1024, NCHUNK = SEQ / 128;
constexpr float EPS = 1e-6f;
constexpr int NTHREADS = 512, LDS_BYTES = 147456;
constexpr int PH_PER_LAYER = 11, NPHASE = 2 * PH_PER_LAYER;
constexpr size_t MiB = 1u << 20;
constexpr size_t WS_W1 = 0;
constexpr size_t WS_W2 = WS_W1 + (size_t)5632 * 1024 * 2;
constexpr size_t WS_WIN = WS_W2 + (size_t)1024 * 2816 * 2;
constexpr size_t WS_WUQ = WS_WIN + (size_t)2816 * 1024 * 2;
constexpr size_t WS_WUKV = WS_WUQ + (size_t)768 * 384 * 2;
constexpr size_t WS_WOUT = WS_WUKV + (size_t)1024 * 256 * 2;
constexpr size_t WS_W3 = WS_WOUT + (size_t)1024 * 1280 * 2;
constexpr size_t WS_W4 = WS_W3 + (size_t)5632 * 1024 * 2;
constexpr size_t WS_WEND = WS_W4 + (size_t)1024 * 2816 * 2;
constexpr size_t WS_XB = 44 * MiB;
constexpr size_t OUT_KV = 0, OUT_QF = 64 * MiB;
constexpr size_t WS_A = WS_XB + 64 * MiB;
constexpr size_t WS_B = WS_A + 176 * MiB;
constexpr size_t WS_LOGA = WS_B, WS_URET = WS_B + 32 * MiB, WS_UGLA = WS_B + 48 * MiB, WS_GDEC = WS_B + 64 * MiB, WS_CQN = WS_B + 65 * MiB, WS_CKVN = WS_B + 89 * MiB, WS_KROPE = WS_B + 105 * MiB;
constexpr size_t WS_MIX = WS_B + 110 * MiB;
constexpr size_t WS_SSQ = WS_MIX + 64 * MiB;
constexpr size_t WS_ROPE = WS_SSQ + 2 * MiB;
constexpr size_t WS_CTL = WS_ROPE + 8 * MiB, CTL_BYTES = 16384;
constexpr size_t WS_END = WS_CTL + 1 * MiB;
static_assert(WS_WEND <= WS_XB && (size_t)M * 2816 * 2 <= 176 * MiB && WS_END <= 512 * MiB, "d_ws map");

__constant__ double INVF[32] = {1.0, 0.7498942093324559, 0.5623413251903491, 0.4216965034285822, 0.31622776601683794, 0.23713737056616552, 0.1778279410038923, 0.1333521432163324, 0.1, 0.07498942093324558, 0.05623413251903491, 0.042169650342858224, 0.03162277660168379, 0.023713737056616554, 0.01778279410038923, 0.01333521432163324, 0.01, 0.007498942093324558, 0.005623413251903491, 0.004216965034285823, 0.0031622776601683794, 0.0023713737056616554, 0.0017782794100389228, 0.001333521432163324, 0.001, 0.0007498942093324559, 0.0005623413251903491, 0.00042169650342858224, 0.00031622776601683794, 0.00023713737056616554, 0.00017782794100389227, 0.0001333521432163324};
__device__ __forceinline__ float ret_log2g(int h) { return h == 0 ? -0.04580368961312479f : h == 1 ? -0.02272007650008353f : h == 2 ? -0.011315313227834146f : -0.005646563141142063f; }

__device__ __forceinline__ unsigned f2bf(float f) { unsigned u = __builtin_bit_cast(unsigned, f); return (u + 0x7fffu + ((u >> 16) & 1u)) >> 16; }
__device__ __forceinline__ unsigned pk2(float lo, float hi) { return f2bf(lo) | (f2bf(hi) << 16); }
__device__ __forceinline__ float bflo(unsigned w) { return __builtin_bit_cast(float, w << 16); }
__device__ __forceinline__ float bfhi(unsigned w) { return __builtin_bit_cast(float, w & 0xffff0000u); }
__device__ __forceinline__ float bf2f(bf16 v) { return __builtin_bit_cast(float, (unsigned)v << 16); }
__device__ __forceinline__ float wave_sum(float v) {
#pragma unroll
    for (int o = 1; o < 64; o <<= 1) v += __shfl_xor(v, o);
    return v;
}
__device__ __forceinline__ float silu(float g) { return g * __builtin_amdgcn_rcpf(1.0f + __expf(-g)); }
#define MFMA32(a, b, c) __builtin_amdgcn_mfma_f32_32x32x16_bf16((a), (b), (c), 0, 0, 0)
__device__ __forceinline__ int crow(int r, int hi) { return (r & 3) + 8 * (r >> 2) + 4 * hi; }

struct Params { const float* in[23]; float* out; unsigned char* ws; int ph_lo, ph_hi; };
struct Frame {
    unsigned char* lds; int tid, lane, wave, G, bid;
    const float* in[23]; float* out; unsigned char* ws;
};

struct TrDesc { const float* W; const float* gain; bf16* WT; int ldw, ldt, k0, kdst0, scol0, nvalid, drow0; };
__device__ __forceinline__ void tr_load(const TrDesc& d, f32x4 (&v)[16], int lane) {
    const int nq = (lane & 15) * 4, kq = lane >> 4;
#pragma unroll
    for (int j = 0; j < 16; ++j) { const int kk = 8 * (j >> 1) + 2 * kq + (j & 1);
        v[j] = (f32x4){0.f, 0.f, 0.f, 0.f};
        if (nq < d.nvalid) v[j] = *(const f32x4*)(d.W + (size_t)(d.k0 + kk) * d.ldw + d.scol0 + nq); }
}
__device__ __forceinline__ void tr_store(const TrDesc& d, f32x4 (&v)[16], unsigned* scr, int lane) {
    const int nq = (lane & 15) * 4, kq = lane >> 4;
    if (d.gain) {
#pragma unroll
        for (int j = 0; j < 16; ++j) { const int kk = 8 * (j >> 1) + 2 * kq + (j & 1); v[j] *= d.gain[d.k0 + kk]; } }
#pragma unroll
    for (int m = 0; m < 8; ++m) { const int kp = 4 * m + kq;
#pragma unroll
        for (int c = 0; c < 4; ++c) scr[(nq + c) * 33 + kp] = pk2(v[2 * m][c], v[2 * m + 1][c]); }
    asm volatile("s_waitcnt lgkmcnt(0)" ::: "memory");
    const int cc = lane & 7;
#pragma unroll
    for (int r = 0; r < 8; ++r) { const int n = 8 * r + (lane >> 3); const unsigned* s = scr + n * 33 + 4 * cc;
        u32x4 o; o[0] = s[0]; o[1] = s[1]; o[2] = s[2]; o[3] = s[3];
        *(u32x4*)(d.WT + (size_t)(d.drow0 + n) * d.ldt + d.kdst0 + 8 * cc) = o; }
    asm volatile("s_waitcnt lgkmcnt(0)" ::: "memory");
}
constexpr int PI1 = 88 * 16, PI2 = 16 * 44, PI3 = 44 * 16, PI4 = 12 * 6, PI5 = 16 * 4, PI6 = 16 * 16;
constexpr int PNITEMS = 2 * PI1 + 2 * PI2 + PI3 + PI4 + PI5 + PI6;
__device__ __forceinline__ TrDesc tr_decode(Frame& F, int l, int it) {
    unsigned char* ws = F.ws; TrDesc d; int r = it;
    if (r < 2 * PI1) {
        const int which = r / PI1; r -= which * PI1; const int db = r / 16, kb = r % 16, pn = db >> 2, bj = (db >> 1) & 1, i64 = db & 1;
        d.W = (which ? F.in[21] : F.in[3]) + (size_t)l * 1024 * 5632; d.gain = (which ? F.in[20] : F.in[2]) + l * 1024; d.WT = (bf16*)(ws + (which ? WS_W3 : WS_W1));
        d.ldw = 5632; d.ldt = 1024; d.k0 = kb * 64; d.kdst0 = kb * 64; d.scol0 = bj * 2816 + pn * 128 + i64 * 64; d.nvalid = 64; d.drow0 = db * 64; return d; }
    r -= 2 * PI1;
    if (r < 2 * PI2) {
        const int which = r / PI2; r -= which * PI2; const int db = r / 44, kb = r % 44;
        d.W = (which ? F.in[22] : F.in[4]) + (size_t)l * 2816 * 1024; d.gain = nullptr; d.WT = (bf16*)(ws + (which ? WS_W4 : WS_W2));
        d.ldw = 1024; d.ldt = 2816; d.k0 = kb * 64; d.kdst0 = kb * 64; d.scol0 = db * 64; d.nvalid = 64; d.drow0 = db * 64; return d; }
    r -= 2 * PI2;
    if (r < PI3) {
        const int db = r / 16, kb = r % 16; int nv = INC - db * 64; nv = nv < 0 ? 0 : (nv > 64 ? 64 : nv);
        d.W = F.in[6] + (size_t)l * 1024 * INC; d.gain = F.in[5] + l * 1024; d.WT = (bf16*)(ws + WS_WIN);
        d.ldw = INC; d.ldt = 1024; d.k0 = kb * 64; d.kdst0 = kb * 64; d.scol0 = db * 64; d.nvalid = nv; d.drow0 = db * 64; return d; }
    r -= PI3;
    if (r < PI4) { const int db = r / 6, kb = r % 6;
        d.W = F.in[9] + (size_t)l * 384 * 768; d.gain = nullptr; d.WT = (bf16*)(ws + WS_WUQ);
        d.ldw = 768; d.ldt = 384; d.k0 = kb * 64; d.kdst0 = kb * 64; d.scol0 = db * 64; d.nvalid = 64; d.drow0 = db * 64; return d; }
    r -= PI4;
    if (r < PI5) { const int db = r / 4, kb = r % 4;
        d.W = F.in[11] + (size_t)l * 256 * 1024; d.gain = nullptr; d.WT = (bf16*)(ws + WS_WUKV);
        d.ldw = 1024; d.ldt = 256; d.k0 = kb * 64; d.kdst0 = kb * 64; d.scol0 = db * 64; d.nvalid = 64; d.drow0 = db * 64; return d; }
    r -= PI5;
    { const int db = r / 16, kb = r % 16;
        d.W = F.in[19] + (size_t)l * 1024 * 1024; d.gain = nullptr; d.WT = (bf16*)(ws + WS_WOUT);
        d.ldw = 1024; d.ldt = MIXK; d.k0 = kb * 64; d.kdst0 = kb * 64; d.scol0 = db * 64; d.nvalid = 64; d.drow0 = db * 64; return d; }
}
__device__ __forceinline__ void prep_phase(Frame& F, int l) {
    unsigned* scr = (unsigned*)(F.lds + F.wave * 8448);
    const int gw = F.bid * 8 + F.wave, NGW = F.G * 8;
    unsigned char* ws = F.ws;
    if (gw < PNITEMS) {
        f32x4 va[16], vb[16];
        TrDesc da = tr_decode(F, l, gw), db_; tr_load(da, va, F.lane);
        for (int it = gw; it < PNITEMS; it += 2 * NGW) {
            const int i1 = it + NGW, i2 = it + 2 * NGW;
            if (i1 < PNITEMS) { db_ = tr_decode(F, l, i1); tr_load(db_, vb, F.lane); }
            tr_store(da, va, scr, F.lane);
            if (i1 < PNITEMS) {
                if (i2 < PNITEMS) { da = tr_decode(F, l, i2); tr_load(da, va, F.lane); }
                tr_store(db_, vb, scr, F.lane);
            }
        }
    }
    if (l == 0) {
        const float* x = F.in[0]; bf16* xb = (bf16*)(ws + WS_XB); float* ssq = (float*)(ws + WS_SSQ);
        for (int m = gw; m < M; m += NGW) {
            const f32x4* xr = (const f32x4*)(x + (size_t)m * D) + F.lane; float s = 0.f;
            u32x2* o8 = (u32x2*)(xb + (size_t)m * D) + F.lane;
#pragma unroll
            for (int j = 0; j < 4; ++j) { const f32x4 v = xr[64 * j]; s += (v[0] * v[0] + v[1] * v[1]) + (v[2] * v[2] + v[3] * v[3]);
                u32x2 w; w[0] = pk2(v[0], v[1]); w[1] = pk2(v[2], v[3]); o8[64 * j] = w; }
            s = wave_sum(s);
            if (F.lane < 16) ssq[(size_t)m * 16 + F.lane] = F.lane == 0 ? s : 0.f;
        }
        const int* pos = (const int*)F.in[1]; float* rc = (float*)(ws + WS_ROPE); float* rsn = rc + (size_t)M * 32;
        for (int e = F.bid * NTHREADS + F.tid; e < M * 32; e += F.G * NTHREADS) {
            const int tok = e >> 5, i = e & 31;
            const double ang = (double)pos[tok] * INVF[i]; double rev = ang * 0.15915494309189535; rev -= __builtin_floor(rev);
            const float rf = (float)rev;
            rc[e] = __builtin_amdgcn_cosf(rf); rsn[e] = __builtin_amdgcn_sinf(rf);
        }
    }
}

struct P1Tok { unsigned cq[3]; u32x2 ckv; u32x4 al0, al1; float c1, s1; bf16 kr; };
__device__ __forceinline__ P1Tok p1_load(const bf16* proj, const float* rc, const float* rsn, int tok, int lane) {
    P1Tok t; const bf16* p = proj + (size_t)tok * INP;
#pragma unroll
    for (int j = 0; j < 3; ++j) t.cq[j] = *(const unsigned*)(p + 1024 + 128 * j + 2 * lane);
    t.ckv = *(const u32x2*)(p + 1408 + 4 * lane); t.kr = p[1664 + lane];
    t.al0 = *(const u32x4*)(p + 2496); t.al1 = *(const u32x4*)(p + 2504);
    t.c1 = rc[(size_t)tok * 32 + (lane & 31)]; t.s1 = rsn[(size_t)tok * 32 + (lane & 31)];
    return t;
}
__device__ __forceinline__ void post1_phase(Frame& F, int l) {
    unsigned char* ws = F.ws; const int lane = F.lane;
    const bf16* proj = (const bf16*)(ws + WS_A);
    bf16 *cqn = (bf16*)(ws + WS_CQN), *ckvn = (bf16*)(ws + WS_CKVN), *krope = (bf16*)(ws + WS_KROPE);
    float* loga = (float*)(ws + WS_LOGA);
    const float* rc = (const float*)(ws + WS_ROPE); const float* rsn = rc + (size_t)M * 32;
    const float* g_q = F.in[8] + l * 384; const float* g_kv = F.in[10] + l * 256; const float* g_kr = F.in[15] + l * 64;
    const float* Wg = F.in[16] + (size_t)l * 16 * 256; const float* bg = F.in[17] + l * 256;
    const int gw = F.bid * 8 + F.wave, NGW = F.G * 8;
    f32x4 wgr[16];
#pragma unroll
    for (int r = 0; r < 16; ++r) wgr[r] = *(const f32x4*)(Wg + r * 256 + 4 * lane);
    const f32x4 bias = *(const f32x4*)(bg + 4 * lane), gkv = *(const f32x4*)(g_kv + 4 * lane);
    float gq[6];
#pragma unroll
    for (int j = 0; j < 3; ++j) { gq[2 * j] = g_q[128 * j + 2 * lane]; gq[2 * j + 1] = g_q[128 * j + 2 * lane + 1]; }
    const float gkr = g_kr[lane];
    if (gw >= M) return;
    P1Tok t = p1_load(proj, rc, rsn, gw, lane);
    P1Tok nx = p1_load(proj, rc, rsn, gw + NGW < M ? gw + NGW : gw, lane);
    for (int tok = gw; tok < M; tok += NGW) {
        const int tn = tok + 2 * NGW < M ? tok + 2 * NGW : tok;
        const P1Tok nx2 = p1_load(proj, rc, rsn, tn, lane);
        float ssq_ = 0.f;
#pragma unroll
        for (int j = 0; j < 3; ++j) { const float x0 = bflo(t.cq[j]), x1 = bfhi(t.cq[j]); ssq_ += x0 * x0 + x1 * x1; }
        const float k0 = bflo(t.ckv[0]), k1 = bfhi(t.ckv[0]), k2 = bflo(t.ckv[1]), k3 = bfhi(t.ckv[1]);
        float sskv = (k0 * k0 + k1 * k1) + (k2 * k2 + k3 * k3);
        const float v = bf2f(t.kr); float sskr = v * v;
#pragma unroll
        for (int o = 1; o < 64; o <<= 1) { ssq_ += __shfl_xor(ssq_, o); sskv += __shfl_xor(sskv, o); sskr += __shfl_xor(sskr, o); }
        { const float r = rsqrtf(ssq_ * (1.0f / 384.0f) + EPS);
#pragma unroll
          for (int j = 0; j < 3; ++j) *(unsigned*)(cqn + (size_t)tok * 384 + 128 * j + 2 * lane) = pk2(bflo(t.cq[j]) * r * gq[2 * j], bfhi(t.cq[j]) * r * gq[2 * j + 1]); }
        { const float r = rsqrtf(sskv * (1.0f / 256.0f) + EPS); u32x2 o; o[0] = pk2(k0 * r * gkv[0], k1 * r * gkv[1]); o[1] = pk2(k2 * r * gkv[2], k3 * r * gkv[3]);
          *(u32x2*)(ckvn + (size_t)tok * 256 + 4 * lane) = o; }
        { const float r = rsqrtf(sskr * (1.0f / 64.0f) + EPS); const float vn = v * r * gkr; const float other = __shfl_xor(vn, 32);
          const float o = lane < 32 ? vn * t.c1 - other * t.s1 : other * t.s1 + vn * t.c1; krope[(size_t)tok * 64 + lane] = (bf16)f2bf(o); }
        {
            float al[16];
#pragma unroll
            for (int j = 0; j < 4; ++j) { al[2 * j] = bflo(t.al0[j]); al[2 * j + 1] = bfhi(t.al0[j]); al[8 + 2 * j] = bflo(t.al1[j]); al[9 + 2 * j] = bfhi(t.al1[j]); }
            f32x4 x = bias;
#pragma unroll
            for (int r = 0; r < 16; ++r) x += wgr[r] * al[r];
            f32x4 o;
#pragma unroll
            for (int j = 0; j < 4; ++j) { const float xv = x[j]; o[j] = (fminf(xv, 0.f) - __logf(1.0f + __expf(-fabsf(xv)))) * (1.0f / 16.0f); }
            *(f32x4*)(loga + (size_t)tok * 256 + 4 * lane) = o;
        }
        t = nx; nx = nx2;
    }
}

struct P2Tok { unsigned ka[4]; };
__device__ __forceinline__ P2Tok p2_load(const bf16* kv, int tok, int lane) {
    P2Tok t; const bf16* kvp = kv + (size_t)tok * 1024;
#pragma unroll
    for (int h = 0; h < 4; ++h) t.ka[h] = *(const unsigned*)(kvp + h * 256 + 2 * lane);
    return t;
}
__device__ __forceinline__ void post2_phase(Frame& F, int l) {
    const int lane = F.lane;
    bf16* kv = (bf16*)((unsigned char*)F.out + OUT_KV);
    const float* g_kn = F.in[14] + l * 128;
    const int gw = F.bid * 8 + F.wave, NGW = F.G * 8;
    const float gk0 = g_kn[2 * lane], gk1 = g_kn[2 * lane + 1];
    if (gw >= M) return;
    P2Tok t = p2_load(kv, gw, lane);
    for (int tok = gw; tok < M; tok += NGW) {
        const int tn = tok + NGW < M ? tok + NGW : tok;
        const P2Tok nx = p2_load(kv, tn, lane);
        bf16* kd = kv + (size_t)tok * 1024;
        float s3[4];
#pragma unroll
        for (int h = 0; h < 4; ++h) { const float k0 = bflo(t.ka[h]), k1 = bfhi(t.ka[h]); s3[h] = k0 * k0 + k1 * k1; }
#pragma unroll
        for (int o = 1; o < 64; o <<= 1)
#pragma unroll
            for (int h = 0; h < 4; ++h) s3[h] += __shfl_xor(s3[h], o);
#pragma unroll
        for (int h = 0; h < 4; ++h) { const float k0 = bflo(t.ka[h]), k1 = bfhi(t.ka[h]); const float r3 = rsqrtf(s3[h] * (1.0f / 128.0f) + EPS);
            *(unsigned*)(kd + h * 256 + 2 * lane) = pk2(k0 * r3 * gk0, k1 * r3 * gk1); }
        t = nx;
    }
}
constexpr int LQ = 72, LT = 136, LB = 65;
__device__ __forceinline__ void gla_cumsum_regs(const f32x4 (&la)[4], float* Bc, int tid) {
#pragma unroll
    for (int i = 0; i < 4; ++i) { const int idx = tid + 512 * i, t = idx >> 4, c4 = (idx & 15) * 4;
        Bc[t * LB + c4] = la[i][0]; Bc[t * LB + c4 + 1] = la[i][1]; Bc[t * LB + c4 + 2] = la[i][2]; Bc[t * LB + c4 + 3] = la[i][3]; }
    __syncthreads();
    const int d = tid & 63, seg = tid >> 6; float run = 0.f;
#pragma unroll
    for (int j = 0; j < 16; ++j) { run += Bc[(16 * seg + j) * LB + d]; Bc[(16 * seg + j) * LB + d] = run; }
    __syncthreads();
    float off = 0.f;
    for (int s2 = 0; s2 < seg; ++s2) off += Bc[(16 * s2 + 15) * LB + d];
    __syncthreads();
#pragma unroll
    for (int j = 0; j < 16; ++j) Bc[(16 * seg + j) * LB + d] += off;
    __syncthreads();
}
struct CsRegs { bf16x8 k[2], v[2]; f32x4 la[4]; };
__device__ __forceinline__ void cs_load(CsRegs& R, unsigned char* ws, int it, int tid) {
    const bool gla = it >= 1024; const int ch = it & 1023, b = ch >> 9, h = (ch >> 7) & 3, n = ch & 127, t0 = b * SEQ + n * 128;
    const bf16* proj = (const bf16*)(ws + WS_A); const int koff = (gla ? 1984 : 256) + h * 64, voff = (gla ? 2240 : 512) + h * 64;
    const int s = tid & 127, cq = (tid >> 7) * 8; const bf16* row = proj + (size_t)(t0 + s) * INP;
    R.k[0] = *(const bf16x8*)(row + koff + cq); R.k[1] = *(const bf16x8*)(row + koff + 32 + cq);
    R.v[0] = *(const bf16x8*)(row + voff + cq); R.v[1] = *(const bf16x8*)(row + voff + 32 + cq);
    if (gla) { const float* loga = (const float*)(ws + WS_LOGA);
#pragma unroll
        for (int i = 0; i < 4; ++i) { const int idx = tid + 512 * i, t = idx >> 4, c4 = (idx & 15) * 4; R.la[i] = *(const f32x4*)(loga + (size_t)(t0 + t) * 256 + h * 64 + c4); } }
    else { const float* rc = (const float*)(ws + WS_ROPE) + (size_t)(t0 + s) * 32 + cq; const float* rsn = rc + (size_t)M * 32;
        R.la[0] = *(const f32x4*)rc; R.la[1] = *(const f32x4*)(rc + 4); R.la[2] = *(const f32x4*)rsn; R.la[3] = *(const f32x4*)(rsn + 4); }
}
__device__ __forceinline__ void chunk_state_phase(Frame& F) {
    unsigned char* ws = F.ws;
    bf16* Vt = (bf16*)F.lds; bf16* Kt = (bf16*)(F.lds + 17408); float* Bc = (float*)(F.lds + 34816);
    float* gdec = (float*)(ws + WS_GDEC);
    int it = F.bid; if (it >= 2048) return;
    CsRegs R; cs_load(R, ws, it, F.tid);
    for (; it < 2048; it += F.G) {
        int tid = F.tid; asm volatile("" : "+v"(tid)); const int lane = tid & 63, r32 = lane & 31, hi = lane >> 5;
        const bool gla = it >= 1024; const int ch = it & 1023, h = (ch >> 7) & 3;
        float* U = (float*)(ws + (gla ? WS_UGLA : WS_URET));
        if (gla) gla_cumsum_regs(R.la, Bc, tid);
        const float l2g = ret_log2g(h);
        { const int s = tid & 127, cq = (tid >> 7) * 8;
            const float zr = __builtin_amdgcn_exp2f((float)(127 - s) * l2g) * 0.125f;
#pragma unroll
            for (int j = 0; j < 8; ++j) { Vt[(cq + j) * LT + s] = (bf16)R.v[0][j]; Vt[(32 + cq + j) * LT + s] = (bf16)R.v[1][j];
                const float x1 = bf2f((bf16)R.k[0][j]), x2 = bf2f((bf16)R.k[1][j]); float k1, k2;
                if (gla) { k1 = x1 * __expf(Bc[127 * LB + cq + j] - Bc[s * LB + cq + j]); k2 = x2 * __expf(Bc[127 * LB + 32 + cq + j] - Bc[s * LB + 32 + cq + j]); }
                else { const float cc = R.la[j >> 2][j & 3], sn = R.la[2 + (j >> 2)][j & 3]; k1 = (x1 * cc - x2 * sn) * zr; k2 = (x1 * sn + x2 * cc) * zr; }
                Kt[(cq + j) * LT + s] = (bf16)f2bf(k1); Kt[(32 + cq + j) * LT + s] = (bf16)f2bf(k2); } }
        __syncthreads();
        if (it + F.G < 2048) cs_load(R, ws, it + F.G, tid);
        if (F.wave < 4) { const int vt = F.wave >> 1, dt = F.wave & 1; f32x16 acc = {};
#pragma unroll
            for (int ks = 0; ks < 8; ++ks) { const bf16x8 a = *(const bf16x8*)(Vt + (32 * vt + r32) * LT + 16 * ks + 8 * hi), bb = *(const bf16x8*)(Kt + (32 * dt + r32) * LT + 16 * ks + 8 * hi);
                acc = MFMA32(a, bb, acc); }
#pragma unroll
            for (int r = 0; r < 16; ++r) U[(size_t)ch * 4096 + (32 * vt + crow(r, hi)) * 64 + 32 * dt + r32] = acc[r];
        }
        if (gla && tid < 64) gdec[ch * 64 + tid] = __expf(Bc[127 * LB + tid]);
        __syncthreads();
    }
}
__device__ __forceinline__ void scan_phase(Frame& F) {
    unsigned char* ws = F.ws; const float* gdec = (const float*)(ws + WS_GDEC);
    float* sumD = (float*)F.lds; float* sumE = sumD + 512;
    const int tid = F.tid, g = tid >> 6, el = tid & 63;
    for (int blk = F.bid; blk < 1024; blk += F.G) {
        const int type = blk >> 9, bh = (blk >> 6) & 7, e = (blk & 63) * 64 + el;
        float* U = (float*)(ws + (type ? WS_UGLA : WS_URET)) + (size_t)(bh * 128 + 16 * g) * 4096 + e;
        const float dret = __builtin_amdgcn_exp2f(128.0f * ret_log2g(bh & 3));
        float u[16], dc[16];
#pragma unroll
        for (int j = 0; j < 16; ++j) { u[j] = U[(size_t)j * 4096]; dc[j] = type ? gdec[(bh * 128 + 16 * g + j) * 64 + (e & 63)] : dret; }
        float D = 1.f, E = 0.f;
#pragma unroll
        for (int j = 0; j < 16; ++j) { E = E * dc[j] + u[j]; D *= dc[j]; }
        sumD[tid] = D; sumE[tid] = E;
        __syncthreads();
        float cur = 0.f;
        for (int g2 = 0; g2 < g; ++g2) cur = cur * sumD[g2 * 64 + el] + sumE[g2 * 64 + el];
#pragma unroll
        for (int j = 0; j < 16; ++j) { U[(size_t)j * 4096] = cur; cur = cur * dc[j] + u[j]; }
        __syncthreads();
    }
}
struct CoRegs { bf16x8 q[2], k[2], v[2]; f32x4 u[2]; f32x4 la[4]; };
__device__ __forceinline__ void co_load(CoRegs& R, unsigned char* ws, int it, int tid) {
    const bool gla = it >= 1024; const int ch = it & 1023, b = ch >> 9, h = (ch >> 7) & 3, n = ch & 127, t0 = b * SEQ + n * 128;
    const bf16* proj = (const bf16*)(ws + WS_A);
    const int qoff = (gla ? 1728 : 0) + h * 64, koff = (gla ? 1984 : 256) + h * 64, voff = (gla ? 2240 : 512) + h * 64;
    const float* U = (const float*)(ws + (gla ? WS_UGLA : WS_URET));
    { const int t = tid >> 2, cq = (tid & 3) * 8; const bf16* row = proj + (size_t)(t0 + t) * INP;
      R.q[0] = *(const bf16x8*)(row + qoff + cq); R.q[1] = *(const bf16x8*)(row + qoff + 32 + cq); R.k[0] = *(const bf16x8*)(row + koff + cq); R.k[1] = *(const bf16x8*)(row + koff + 32 + cq);
      if (!gla) { const float* rc = (const float*)(ws + WS_ROPE) + (size_t)(t0 + t) * 32 + cq; const float* rsn = rc + (size_t)M * 32;
          R.la[0] = *(const f32x4*)rc; R.la[1] = *(const f32x4*)(rc + 4); R.la[2] = *(const f32x4*)rsn; R.la[3] = *(const f32x4*)(rsn + 4); } }
    { const int s = tid & 127, cv = (tid >> 7) * 8; const bf16* row = proj + (size_t)(t0 + s) * INP; R.v[0] = *(const bf16x8*)(row + voff + cv); R.v[1] = *(const bf16x8*)(row + voff + 32 + cv); }
#pragma unroll
    for (int i = 0; i < 2; ++i) { const int idx = tid + 512 * i, v = idx >> 4, c4 = (idx & 15) * 4; R.u[i] = *(const f32x4*)(U + (size_t)ch * 4096 + v * 64 + c4); }
    if (gla) { const float* loga = (const float*)(ws + WS_LOGA);
#pragma unroll
        for (int i = 0; i < 4; ++i) { const int idx = tid + 512 * i, t = idx >> 4, c4 = (idx & 15) * 4; R.la[i] = *(const f32x4*)(loga + (size_t)(t0 + t) * 256 + h * 64 + c4); } }
}
__device__ __forceinline__ void chunk_out_phase(Frame& F, int l) {
    unsigned char* ws = F.ws;
    bf16* Qs = (bf16*)F.lds; bf16* Ks = (bf16*)(F.lds + 18432); bf16* Vt = (bf16*)(F.lds + 36864); bf16* St = (bf16*)(F.lds + 54272); bf16* Q2 = (bf16*)(F.lds + 63488); float* Bc = (float*)(F.lds + 81920);
    bf16* mix = (bf16*)(ws + WS_MIX); const bf16* proj = (const bf16*)(ws + WS_A);
    int it = F.bid; if (it >= 2048) return;
    CoRegs R; co_load(R, ws, it, F.tid);
    for (; it < 2048; it += F.G) {
        int tid = F.tid; asm volatile("" : "+v"(tid)); const int lane = tid & 63, r32 = lane & 31, hi = lane >> 5;
        const bool gla = it >= 1024; const int ch = it & 1023, b = ch >> 9, h = (ch >> 7) & 3, n = ch & 127, t0 = b * SEQ + n * 128;
        const int mixoff = gla ? 768 : 0, goff = gla ? 2512 : 768;
        const float* gain = (gla ? F.in[18] : F.in[7]) + l * 256;
        if (gla) gla_cumsum_regs(R.la, Bc, tid);
        const float l2g = gla ? 0.f : ret_log2g(h);
        { const int t = tid >> 2, cq = (tid & 3) * 8;
          bf16x8 qa, qb, ka, kb, q2a, q2b;
          if (gla) {
#pragma unroll
              for (int j = 0; j < 8; ++j) {
                  const float bt0 = Bc[t * LB + cq + j], bm0 = Bc[63 * LB + cq + j], bt1 = Bc[t * LB + 32 + cq + j], bm1 = Bc[63 * LB + 32 + cq + j];
                  const float q0 = bf2f((bf16)R.q[0][j]) * 0.125f, q1 = bf2f((bf16)R.q[1][j]) * 0.125f, k0 = bf2f((bf16)R.k[0][j]), k1 = bf2f((bf16)R.k[1][j]);
                  q2a[j] = (short)f2bf(q0 * __expf(bt0)); qa[j] = (short)f2bf(q0 * __expf(bt0 - bm0)); ka[j] = (short)f2bf(k0 * __expf(bm0 - bt0));
                  q2b[j] = (short)f2bf(q1 * __expf(bt1)); qb[j] = (short)f2bf(q1 * __expf(bt1 - bm1)); kb[j] = (short)f2bf(k1 * __expf(bm1 - bt1)); }
          } else { const float xi = __builtin_amdgcn_exp2f((float)(t + 1) * l2g);
#pragma unroll
              for (int j = 0; j < 8; ++j) { const float cc = R.la[j >> 2][j & 3], sn = R.la[2 + (j >> 2)][j & 3];
                  const float x1 = bf2f((bf16)R.q[0][j]), x2 = bf2f((bf16)R.q[1][j]), y1 = bf2f((bf16)R.k[0][j]), y2 = bf2f((bf16)R.k[1][j]);
                  const float q0 = x1 * cc - x2 * sn, q1 = x1 * sn + x2 * cc, k0 = (y1 * cc - y2 * sn) * 0.125f, k1 = (y1 * sn + y2 * cc) * 0.125f;
                  qa[j] = (short)f2bf(q0); qb[j] = (short)f2bf(q1); ka[j] = (short)f2bf(k0); kb[j] = (short)f2bf(k1); q2a[j] = (short)f2bf(q0 * xi); q2b[j] = (short)f2bf(q1 * xi); } }
          *(bf16x8*)(Qs + t * LQ + cq) = qa; *(bf16x8*)(Qs + t * LQ + 32 + cq) = qb; *(bf16x8*)(Ks + t * LQ + cq) = ka; *(bf16x8*)(Ks + t * LQ + 32 + cq) = kb;
          *(bf16x8*)(Q2 + t * LQ + cq) = q2a; *(bf16x8*)(Q2 + t * LQ + 32 + cq) = q2b; }
        { const int s = tid & 127, cv = (tid >> 7) * 8;
#pragma unroll
          for (int j = 0; j < 8; ++j) { Vt[(cv + j) * LT + s] = (bf16)R.v[0][j]; Vt[(32 + cv + j) * LT + s] = (bf16)R.v[1][j]; } }
#pragma unroll
        for (int i = 0; i < 2; ++i) { const int idx = tid + 512 * i, v = idx >> 4, c4 = (idx & 15) * 4; const f32x4 sv = R.u[i];
            u32x2 w; w[0] = pk2(sv[0], sv[1]); w[1] = pk2(sv[2], sv[3]); *(u32x2*)(St + v * LQ + c4) = w; }
        __syncthreads();
        if (it + F.G < 2048) co_load(R, ws, it + F.G, tid);
        if (F.wave < 4) { const int tr = F.wave;
            unsigned gt[16];
#pragma unroll
            for (int r = 0; r < 16; ++r) { const bf16* gp = proj + (size_t)(t0 + 32 * tr + crow(r, hi)) * INP + goff + h * 64; gt[r] = (unsigned)gp[r32] | ((unsigned)gp[32 + r32] << 16); }
            const float gn0 = gain[h * 64 + r32], gn1 = gain[h * 64 + 32 + r32];
            f32x16 oi[2] = {};
            const int tl = 32 * tr + r32;
            for (int sj = 0; sj <= (tr >> 1); ++sj) {
                f32x16 p0 = {}, p1 = {};
#pragma unroll
                for (int ks = 0; ks < 4; ++ks) { const bf16x8 bq = *(const bf16x8*)(Qs + tl * LQ + 16 * ks + 8 * hi);
                    const bf16x8 a0 = *(const bf16x8*)(Ks + (64 * sj + r32) * LQ + 16 * ks + 8 * hi), a1 = *(const bf16x8*)(Ks + (64 * sj + 32 + r32) * LQ + 16 * ks + 8 * hi);
                    p0 = MFMA32(a0, bq, p0); p1 = MFMA32(a1, bq, p1); }
#pragma unroll
                for (int r = 0; r < 16; ++r) { const int s0 = 64 * sj + crow(r, hi), df0 = tl - s0, df1 = df0 - 32;
                    const float w0 = __builtin_amdgcn_exp2f((float)df0 * l2g), w1 = __builtin_amdgcn_exp2f((float)df1 * l2g);
                    p0[r] = df0 >= 0 ? p0[r] * w0 : 0.f; p1[r] = df1 >= 0 ? p1[r] * w1 : 0.f; }
#pragma unroll
                for (int q4 = 0; q4 < 4; ++q4) { const int st = (q4 & 1) * 8; u32x4 aw;
                    if (q4 < 2) { aw[0] = pk2(p0[st], p0[st + 1]); aw[1] = pk2(p0[st + 2], p0[st + 3]); aw[2] = pk2(p0[st + 4], p0[st + 5]); aw[3] = pk2(p0[st + 6], p0[st + 7]); }
                    else        { aw[0] = pk2(p1[st], p1[st + 1]); aw[1] = pk2(p1[st + 2], p1[st + 3]); aw[2] = pk2(p1[st + 4], p1[st + 5]); aw[3] = pk2(p1[st + 6], p1[st + 7]); }
                    const bf16x8 a = __builtin_bit_cast(bf16x8, aw); const int sb = 64 * sj + 16 * q4;
#pragma unroll
                    for (int vc = 0; vc < 2; ++vc) { const bf16* vp = Vt + (32 * vc + r32) * LT + sb + 4 * hi;
                        const s16x4 lo = *(const s16x4*)vp, hh = *(const s16x4*)(vp + 8);
                        const bf16x8 bv = {lo[0], lo[1], lo[2], lo[3], hh[0], hh[1], hh[2], hh[3]};
                        oi[vc] = MFMA32(a, bv, oi[vc]); } }
            }
#pragma unroll
            for (int ks = 0; ks < 4; ++ks) { const bf16x8 a = *(const bf16x8*)(Q2 + tl * LQ + 16 * ks + 8 * hi);
#pragma unroll
                for (int vc = 0; vc < 2; ++vc) { const bf16x8 bs = *(const bf16x8*)(St + (32 * vc + r32) * LQ + 16 * ks + 8 * hi); oi[vc] = MFMA32(a, bs, oi[vc]); } }
#pragma unroll
            for (int r = 0; r < 16; ++r) { const int tt = 32 * tr + crow(r, hi);
                const float o0 = oi[0][r], o1 = oi[1][r];
                float ss = o0 * o0 + o1 * o1;
                ss += __shfl_xor(ss, 1); ss += __shfl_xor(ss, 2); ss += __shfl_xor(ss, 4); ss += __shfl_xor(ss, 8); ss += __shfl_xor(ss, 16);
                const float rstd = rsqrtf(ss * (1.0f / 64.0f) + EPS);
                bf16* mp = mix + (size_t)(t0 + tt) * MIXK + mixoff + h * 64;
                mp[r32] = (bf16)f2bf(o0 * rstd * gn0 * silu(bflo(gt[r]))); mp[32 + r32] = (bf16)f2bf(o1 * rstd * gn1 * silu(bfhi(gt[r]))); }
        }
        __syncthreads();
    }
}
#define XB_TMO      128
#define XB_XCNT(j)  (256  + 64 * (j))
#define XB_XSUB(j)  (1280 + 64 * (j))
#define XB_XGEN(j)  (2304 + 64 * (j))
#define XB_TOP      3328
#define XB_TOPGEN   3392
#define XCD_BAR_WORDS 3456
#define XB_SPIN_CAP (1u << 18)

__device__ __forceinline__ unsigned xb_ld(unsigned* p)              { return __hip_atomic_load(p, __ATOMIC_RELAXED, __HIP_MEMORY_SCOPE_AGENT); }
__device__ __forceinline__ unsigned xb_add(unsigned* p, unsigned v) { return __hip_atomic_fetch_add(p, v, __ATOMIC_RELAXED, __HIP_MEMORY_SCOPE_AGENT); }
__device__ __forceinline__ unsigned xb_xcc_id() { return (unsigned)__builtin_amdgcn_s_getreg((3 << 11) | 20) & 0xFu; }
#define XB_SPIN(cond, bar) do { unsigned _sp = 0; while (cond) { __builtin_amdgcn_s_sleep(1); \
    if ((++_sp & 255u) == 0u) { if (xb_ld(&(bar)[XB_TMO])) break; if (_sp > XB_SPIN_CAP) { atomicAdd(&(bar)[XB_TMO], 1u); break; } } } } while (0)

struct XcdBarrier {
    unsigned* bar; unsigned x;
    volatile LAS unsigned* st;
};

__device__ __forceinline__ XcdBarrier xcd_barrier_post(unsigned* bar, volatile LAS unsigned* st) {
    XcdBarrier b; b.bar = bar; b.x = xb_xcc_id(); b.st = st;
    if (threadIdx.x == 0) (void)xb_add(&bar[XB_XCNT(b.x)], 1u);
    return b;
}
__device__ __forceinline__ void xcd_barrier_complete(unsigned* bar, unsigned x, unsigned& nloc, unsigned& nx) {
    const unsigned G = gridDim.x * gridDim.y * gridDim.z;
    unsigned sum, cnt, mine, sp = 0u;
    for (;;) {
        sum = 0u; cnt = 0u; mine = 0u;
#pragma unroll
        for (unsigned j = 0; j < 16; ++j) { const unsigned c = xb_ld(&bar[XB_XCNT(j)]); sum += c; cnt += (c > 0u) ? 1u : 0u; mine = (j == x) ? c : mine; }
        if (sum == G) break;
        __builtin_amdgcn_s_sleep(1);
        if ((++sp & 255u) == 0u) { if (xb_ld(&bar[XB_TMO])) break; if (sp > XB_SPIN_CAP) { atomicAdd(&bar[XB_TMO], 1u); break; } }
    }
    nloc = mine > 0u ? mine : 1u; nx = cnt > 0u ? cnt : 1u;
}

__device__ __forceinline__ void xcd_barrier(const XcdBarrier& b) {
    asm volatile("s_waitcnt vmcnt(0)" ::: "memory");
    __syncthreads();
    if (threadIdx.x == 0) {
        unsigned* bar = b.bar;
        __builtin_amdgcn_s_waitcnt(0);
        unsigned nloc = b.st[0], nx = b.st[1];
        if (nloc == 0u) { xcd_barrier_complete(bar, b.x, nloc, nx); b.st[0] = nloc; b.st[1] = nx; }
        const unsigned old = xb_add(&bar[XB_XSUB(b.x)], 1u);
        const unsigned gen = old / nloc;
        if (old + 1u == (gen + 1u) * nloc) {
            __builtin_amdgcn_fence(__ATOMIC_RELEASE, "agent");
            asm volatile("s_waitcnt vmcnt(0)" ::: "memory");
            const unsigned og = xb_add(&bar[XB_TOP], 1u);
            const unsigned tg = og / nx;
            if (og + 1u == (tg + 1u) * nx) xb_add(&bar[XB_TOPGEN], 1u);
            else XB_SPIN(xb_ld(&bar[XB_TOPGEN]) == tg, bar);
            __builtin_amdgcn_fence(__ATOMIC_ACQUIRE, "agent");
            xb_add(&bar[XB_XGEN(b.x)], 1u);
            asm volatile("s_waitcnt vmcnt(0)" ::: "memory");
        } else {
            XB_SPIN(xb_ld(&bar[XB_XGEN(b.x)]) == gen, bar);
            __builtin_amdgcn_fence(__ATOMIC_ACQUIRE, "agent");
            asm volatile("s_waitcnt vmcnt(0)" ::: "memory");
        }
    }
    __syncthreads();
}
__device__ __forceinline__ att::BlockRef mk_attn_ref(unsigned char* ws, unsigned char* ob, int L, int pass, bool dummy = false) {
    const int bh = L >> 5, x = L & 31, qb = pass ? x : 63 - x, b = bh >> 2, h = bh & 3;
    att::BlockRef r;
    r.Q = (const bf16*)(ob + OUT_QF) + (size_t)(b * SEQ + qb * 256) * 768 + h * 192;
    r.O = (bf16*)(ws + WS_MIX) + (size_t)(b * SEQ + qb * 256) * MIXK + 256 + h * 128;
    r.K = (const bf16*)(ob + OUT_KV) + (size_t)(b * SEQ) * 1024 + h * 256;
    r.KR = (const bf16*)(ws + WS_KROPE) + (size_t)(b * SEQ) * 64;
    r.P0 = qb * 256; r.tok0 = b * SEQ + qb * 256;
    return r;
}
__device__ __forceinline__ void attn_phase(Frame& F, int l, bool dummy = false) {
    const int G = F.G, vcu = (G % 8 == 0) ? (F.bid % 8) * (G / 8) + F.bid / 8 : F.bid;
    float gq = 0.f, gr = 0.f, gk = 0.f, gkr = 0.f;
    { const float* a = F.in[12] + l * 128; const float* b = F.in[13] + l * 64; const float* c = F.in[14] + l * 128; const float* d = F.in[15] + l * 64;
      gq = fmaxf(fabsf(a[F.lane]), fabsf(a[64 + F.lane])); gk = fmaxf(fabsf(c[F.lane]), fabsf(c[64 + F.lane])); gr = fabsf(b[F.lane]); gkr = fabsf(d[F.lane]);
#pragma unroll
      for (int o = 1; o < 64; o <<= 1) { gq = fmaxf(gq, __shfl_xor(gq, o)); gk = fmaxf(gk, __shfl_xor(gk, o)); gr = fmaxf(gr, __shfl_xor(gr, o)); gkr = fmaxf(gkr, __shfl_xor(gkr, o)); } }
    const float bound = 1.03f * att::SCALE * sqrtf(128.f * gq * gq + 64.f * gr * gr) * sqrtf(128.f * gk * gk + 64.f * gkr * gkr);
    const float mB = bound * 1.4426950408889634f;
    att::QNorm qn; qn.gqn = F.in[12] + l * 128; qn.gkn = F.in[14] + l * 128; qn.gqr = F.in[13] + l * 64; qn.rc = (const float*)(F.ws + WS_ROPE); qn.rsn = qn.rc + (size_t)M * 32;
    const bool use_static = bound < 40.0f;
    for (int L = vcu; L < 256; L += G)
        for (int pass = 0; pass < 2; ++pass) { const att::BlockRef cur = mk_attn_ref(F.ws, (unsigned char*)F.out, L, pass, dummy);
            if (use_static) att::attn_block<true>(cur, (char*)F.lds, mB, qn); else att::attn_block<false>(cur, (char*)F.lds, mB, qn); }
}

__global__ void __launch_bounds__(NTHREADS) mega_fwd(Params p) {
    extern __shared__ __attribute__((aligned(16))) unsigned char lds[];
    cg::grid_group grid = cg::this_grid();
    PG8_LAS unsigned char* ring = (PG8_LAS unsigned char*)lds;
    volatile LAS unsigned* bst = (volatile LAS unsigned*)((LAS unsigned char*)lds + 131072 + 256);
    if (threadIdx.x < 2) bst[threadIdx.x] = 0u;
    __syncthreads();
    XcdBarrier xbar = xcd_barrier_post((unsigned*)(p.ws + WS_CTL), bst);
    int rep = 0; (void)rep;
#if PROBE_SYNC
    for (int i = 0; i < PROBE_SYNC; ++i) xcd_barrier(xbar);
#endif
    for (int ph = p.ph_lo; ph < p.ph_hi; ++ph) {
        int tid_ = threadIdx.x, bid_ = blockIdx.x, G_ = gridDim.x;
        __attribute__((address_space(1))) unsigned char* wsg = (__attribute__((address_space(1))) unsigned char*)p.ws; __attribute__((address_space(1))) float* outg = (__attribute__((address_space(1))) float*)p.out;
        asm volatile("" : "+v"(tid_)); asm volatile("" : "+s"(bid_)); asm volatile("" : "+s"(G_)); asm volatile("" : "+s"(wsg)); asm volatile("" : "+s"(outg));
        unsigned char* ws = (unsigned char*)wsg; float* out_ = (float*)outg;
        Frame F; F.lds = lds; F.tid = tid_; F.lane = F.tid & 63; F.wave = __builtin_amdgcn_readfirstlane(F.tid >> 6); F.G = G_; F.bid = bid_;
#pragma unroll
        for (int i = 0; i < 23; ++i) F.in[i] = (const float*)(const __attribute__((address_space(1))) float*)p.in[i];
        F.out = out_; F.ws = ws;
        bf16* xb = (bf16*)(ws + WS_XB); bf16* actb = (bf16*)(ws + WS_A); float* ssq = (float*)(ws + WS_SSQ); bf16* mix = (bf16*)(ws + WS_MIX);
        const int l = ph / PH_PER_LAYER, q = ph % PH_PER_LAYER;
#ifndef PH_MASK
#define PH_MASK 0x7ff
#endif
#define PHON(k) ((PH_MASK >> (k)) & 1)
        if (q == 0) { if (PHON(0)) prep_phase(F, l); }
        else if (PHON(1) && (q == 1 || q == 9)) {
            pg8::Gemm g{xb, (const bf16*)(ws + (q == 1 ? WS_W1 : WS_W3)), M, 2 * DFF, D};
            pg8::StaticOrder S; S.init(M, 2 * DFF, F.G, F.bid);
            pg8::EpiSwiGLU E{actb, ssq, DFF};
            pg8::gemm_phase<pg8::EpiSwiGLU, pg8::StaticOrder, true, true>(ring, g, S, E);
#if PROBE_FFNUP
            grid.sync(); pg8::gemm_phase<pg8::EpiSwiGLU, pg8::StaticOrder, true, true>(ring, g, S, E);
#endif
        } else if (PHON(2) && (q == 2 || q == 8 || q == 10)) {
            const bf16* A = q == 8 ? mix : actb; const bf16* Bt = (const bf16*)(ws + (q == 2 ? WS_W2 : q == 8 ? WS_WOUT : WS_W4)); const int K = q == 8 ? MIXK : DFF;
            pg8::Gemm g{A, Bt, M, D, K};
            pg8::StaticOrder S; S.init(M, D, F.G, F.bid);
            pg8::EpiResid E{(ph == NPHASE - 1) ? F.out : nullptr, xb, ssq, q == 8 ? 1.0f : 0.5f};
            pg8::gemm_phase<pg8::EpiResid, pg8::StaticOrder, true, true>(ring, g, S, E);
        } else if (PHON(3) && (q == 3 || q == 5)) {
            const int nj = q == 5 ? 3 : 1;
            for (int j = 0; j < nj; ++j) {
                pg8::Gemm g; pg8::EpiPlain E; int oid = F.bid;
                if (q == 3)      { g = pg8::Gemm{xb, (const bf16*)(ws + WS_WIN), M, INP - 256, D};                       E = pg8::EpiPlain{actb, INP, 0, ssq, nullptr, nullptr}; }
                else if (j == 0) { g = pg8::Gemm{(const bf16*)(ws + WS_CQN), (const bf16*)(ws + WS_WUQ), M, 768, 384};    E = pg8::EpiPlain{(bf16*)((unsigned char*)F.out + OUT_QF), 768, 0, nullptr, nullptr, nullptr}; }
                else if (j == 1) { g = pg8::Gemm{(const bf16*)(ws + WS_CKVN), (const bf16*)(ws + WS_WUKV), M, 1024, 256}; E = pg8::EpiPlain{(bf16*)((unsigned char*)F.out + OUT_KV), 1024, 0, nullptr, F.in[14] + l * 128, (PG8_LAS float*)((PG8_LAS unsigned char*)lds + 131072 + 1024)}; }
                else             { g = pg8::Gemm{xb, (const bf16*)(ws + WS_WIN) + (size_t)(INP - 256) * D, M, 256, D};   E = pg8::EpiPlain{actb, INP, INP - 256, ssq, nullptr, nullptr}; oid = (F.bid + F.G / 2) % F.G; }
                pg8::StaticOrder S; S.init(M, g.N, F.G, oid);
                pg8::gemm_phase<pg8::EpiPlain, pg8::StaticOrder, true, true>(ring, g, S, E);
            }
            if (PHON(5) && q == 5) { __syncthreads(); chunk_state_phase(F); }
        } else if (PHON(4) && q == 4) post1_phase(F, l);
        else if (PHON(6) && q == 6) { scan_phase(F); }
        else if (q == 7) { if (PHON(7)) { chunk_out_phase(F, l);
#if PROBE_CO
            xcd_barrier(xbar); chunk_out_phase(F, l);
#endif
            } __syncthreads();
#if PROBE_ATTN
            grid.sync(); attn_phase(F, l, true);
#endif
            if (PHON(8)) attn_phase(F, l); }
#if PROBE_REP
        if ((PROBE_REP >> q) & 1) { if (rep == 0) { rep = 1; grid.sync(); --ph; continue; } rep = 0; }
#endif
        if (ph + 1 < p.ph_hi) { if (ph == p.ph_lo) grid.sync(); else xcd_barrier(xbar); }
    }
}

extern "C" void kernel_launch(void* const* d_in, const int* in_sizes, int n_in, void* d_out, int out_size, void* d_ws, size_t ws_size, hipStream_t stream) {
    static int grid = 0;
    if (grid == 0) {
        if (n_in != 23 || in_sizes[0] != M * D || out_size != M * D || ws_size < WS_END) { fprintf(stderr, "kernel_launch: unexpected shapes (n_in %d, in0 %d, out %d, ws %zu; need ws >= %zu)\n", n_in, n_in > 0 ? in_sizes[0] : -1, out_size, ws_size, (size_t)WS_END); grid = -1; return; }
        int dev = 0, cus = 0, per_cu = 0;
        (void)hipGetDevice(&dev); (void)hipDeviceGetAttribute(&cus, hipDeviceAttributeMultiprocessorCount, dev);
        if (hipFuncSetAttribute((const void*)mega_fwd, hipFuncAttributeMaxDynamicSharedMemorySize, LDS_BYTES) != hipSuccess) fprintf(stderr, "kernel_launch: hipFuncSetAttribute failed\n");
        if (hipOccupancyMaxActiveBlocksPerMultiprocessor(&per_cu, (const void*)mega_fwd, NTHREADS, LDS_BYTES) != hipSuccess || per_cu < 1) { fprintf(stderr, "kernel_launch: occupancy query gave %d; using 1\n", per_cu); per_cu = 1; }
        (void)hipGetLastError();
        if (cus <= 0) cus = 256;
        grid = cus * per_cu;
    }
    if (grid < 0) return;
    Params p{};
    for (int i = 0; i < 23; ++i) p.in[i] = (const float*)d_in[i];
    p.out = (float*)d_out; p.ws = (unsigned char*)d_ws;
#if ONE_LAUNCH
    if (hipMemsetAsync((char*)d_ws + WS_CTL, 0, CTL_BYTES, stream) != hipSuccess) fprintf(stderr, "kernel_launch: hipMemsetAsync failed\n");
    p.ph_lo = 0; p.ph_hi = NPHASE;
    void* args[] = {&p};
    hipError_t e = hipLaunchCooperativeKernel((const void*)mega_fwd, dim3(grid), dim3(NTHREADS), args, LDS_BYTES, stream);
    if (e != hipSuccess) fprintf(stderr, "kernel_launch: cooperative launch failed: %s (grid %d)\n", hipGetErrorString(e), grid);
#else
    for (int ph = 0; ph < NPHASE; ++ph) { p.ph_lo = ph; p.ph_hi = ph + 1; hipLaunchKernelGGL(mega_fwd, dim3(grid), dim3(NTHREADS), LDS_BYTES, stream, p); }
#endif
}
```

```cpp
#include <hip/hip_runtime.h>
#include <hip/hip_cooperative_groups.h>
#include <hip/hip_bf16.h>
#include <cstdio>
#include <cstdint>
namespace cg = cooperative_groups;
namespace pg8 {
#define PG8_LAS __attribute__((address_space(3)))
typedef unsigned short bf16_t;
typedef short bf16x8 __attribute__((ext_vector_type(8)));
typedef float f32x4 __attribute__((ext_vector_type(4)));
typedef unsigned u32x4 __attribute__((ext_vector_type(4)));
constexpr int BM = 256, BK = 64, HALF = 128, HTB = HALF * BK * 2  , STAGE_BYTES = 8 * HTB, NXCD = 8, WGM = 4;

__host__ __device__ __forceinline__ int lds_byte(int r, int c) { const int st = (r >> 4) * 2 + (c >> 5), rr = r & 15, cc = c & 31, ob = rr * 64 + cc * 2; return st * 1024 + (ob ^ (((ob >> 9) & 1) << 5)); }
__host__ __device__ __forceinline__ void stage_rc(int b, int& R, int& C) { const int st = b / 1024, sb = b % 1024, swz = sb ^ (((sb >> 9) & 1) << 5); R = (st >> 1) * 16 + swz / 64; C = (st & 1) * 32 + (swz % 64) / 2; }
__host__ __device__ __forceinline__ int perm32(int rho) { const int n = rho >> 4, i = rho & 15; return 8 * (i >> 2) + 4 * n + (i & 3); }

struct Unit { int pm, pn; };
struct Gemm { const bf16_t* A; const bf16_t* Bt; int M, N, K; };

struct StaticOrder {
    int nM, nN, nwg, G, c;
    __host__ __device__ void init(int M, int N, int G_, int c_) { nM = M / BM; nN = N / BM; nwg = nM * nN; G = G_; c = c_; }
    __host__ __device__ bool next(int i, Unit& u) const {
        const long L = (long)i * G + c; if (L >= nwg) return false;
        int wgid = (int)L; { const int q = nwg / NXCD, r = nwg % NXCD, xcd = wgid % NXCD, off = wgid / NXCD; wgid = (xcd < r ? xcd * (q + 1) : r * (q + 1) + (xcd - r) * q) + off; }
        const int nig = WGM * nN, gid = wgid / nig, fm = gid * WGM, gsz = (nM - fm) < WGM ? (nM - fm) : WGM;
        u.pm = fm + ((wgid % nig) % gsz); u.pn = (wgid % nig) / gsz; return true;
    }
    __device__ __forceinline__ void a_ready(const Unit&) const {}
    __device__ __forceinline__ void done(const Unit&) const {}
};

__device__ __forceinline__ unsigned cvt_pk_bf16(float lo, float hi) { unsigned r; asm volatile("v_cvt_pk_bf16_f32 %0, %1, %2" : "=v"(r) : "v"(lo), "v"(hi)); return r; }
template <class Epi, class Sched, bool ALIGN_EPI = false, bool SP2 = false>
__device__ __forceinline__ void gemm_phase(PG8_LAS unsigned char* lds, const Gemm g, const Sched& S, const Epi& E) {
    int tid_l = threadIdx.x; asm volatile("" : "+v"(tid_l)); const int tid = tid_l, wid = __builtin_amdgcn_readfirstlane(tid >> 6), lane = tid & 63, wr = wid >> 2, wc = wid & 3, fr = lane & 15, fq = lane >> 4;
    const int K = g.K, nt = K / BK;
    unsigned voffA[2], voffB[2];
#pragma unroll
    for (int i = 0; i < 2; ++i) { int R, C; stage_rc(tid * 16 + i * 8192, R, C); const int Rb = Epi::PERM ? ((R & ~31) + perm32(R & 31)) : R;
        voffA[i] = (unsigned)(R * K + C) * 2u; voffB[i] = (unsigned)(Rb * K + C) * 2u; }
    const size_t kstep = (size_t)(BK * 2);
    const size_t hstep = (size_t)HALF * K * 2;
    const size_t tstep = 2 * hstep;
    const unsigned ldsw = (unsigned)wid * 1024u;
    const int aoff = lds_byte(wr * 64 + fr, fq * 8), boff = lds_byte(wc * 32 + fr, fq * 8);
#define PG8_SA(b, h) (((b) * 2 + (h)) * HTB)
#define PG8_SB(b, h) ((4 + (b) * 2 + (h)) * HTB)
#define PG8_STAGE(bufoff, gbase, voff) do { _Pragma("unroll") for (int _i = 0; _i < 2; ++_i) \
        __builtin_amdgcn_global_load_lds((const unsigned*)((const char*)(gbase) + (voff)[_i]), (PG8_LAS unsigned*)(lds + (bufoff) + ldsw + _i * 8192), 16, 0, 0); } while (0)
#define PG8_LDA(dst, b, h) do { _Pragma("unroll") for (int m = 0; m < 4; ++m) _Pragma("unroll") for (int k = 0; k < 2; ++k) dst[m][k] = *(const PG8_LAS bf16x8*)(lds + PG8_SA(b, h) + aoff + m * 2048 + k * 1024); } while (0)
#define PG8_LDB(dst, b, h) do { _Pragma("unroll") for (int n = 0; n < 2; ++n) _Pragma("unroll") for (int k = 0; k < 2; ++k) dst[n][k] = *(const PG8_LAS bf16x8*)(lds + PG8_SB(b, h) + boff + n * 2048 + k * 1024); } while (0)
#define PG8_MMA(ai, bj, At, Bt) do { __builtin_amdgcn_s_setprio(1); _Pragma("unroll") for (int m = 0; m < 4; ++m) _Pragma("unroll") for (int n = 0; n < 2; ++n) _Pragma("unroll") for (int k = 0; k < 2; ++k) \
        acc[ai][bj][m][n] = __builtin_amdgcn_mfma_f32_16x16x32_bf16(Bt[n][k], At[m][k], acc[ai][bj][m][n], 0, 0, 0); __builtin_amdgcn_s_setprio(0); } while (0)
#define PG8_WAIT_V(n) asm volatile("s_waitcnt vmcnt(" #n ")" ::: "memory")
#define PG8_WAIT_L(n) asm volatile("s_waitcnt lgkmcnt(" #n ")" ::: "memory")
#define PG8_BAR __builtin_amdgcn_s_barrier()
#define PG8_SCHED __builtin_amdgcn_sched_barrier(0)
    Unit cur, nxt; int ui = 0;
    if (!S.next(0, cur)) return;
    f32x4 acc[2][2][4][2];
#pragma unroll
    for (int a = 0; a < 2; ++a)
#pragma unroll
        for (int b = 0; b < 2; ++b)
#pragma unroll
            for (int m = 0; m < 4; ++m)
#pragma unroll
                for (int n = 0; n < 2; ++n) acc[a][b][m][n] = (f32x4){0.f, 0.f, 0.f, 0.f};
    bf16x8 At[4][2], B0[2][2], B1[2][2];
    const char* cA = (const char*)g.A + (size_t)cur.pm * tstep; const char* cB = (const char*)g.Bt + (size_t)cur.pn * tstep;
    S.a_ready(cur);
    if constexpr (SP2) {
        PG8_STAGE(PG8_SB(0, 0), cB, voffB); PG8_STAGE(PG8_SB(0, 1), cB + hstep, voffB); PG8_STAGE(PG8_SA(0, 0), cA, voffA); PG8_STAGE(PG8_SA(0, 1), cA + hstep, voffA);
        if (wr == 1) PG8_BAR;
        PG8_WAIT_V(2); PG8_BAR;
        PG8_STAGE(PG8_SB(1, 0), cB + kstep, voffB); PG8_STAGE(PG8_SA(1, 0), cA + kstep, voffA); PG8_STAGE(PG8_SB(1, 1), cB + hstep + kstep, voffB);
        PG8_WAIT_V(6); PG8_BAR;
    } else {
        PG8_STAGE(PG8_SB(0, 0), cB, voffB); PG8_STAGE(PG8_SA(0, 0), cA, voffA); PG8_STAGE(PG8_SB(0, 1), cB + hstep, voffB); PG8_STAGE(PG8_SA(0, 1), cA + hstep, voffA);
        if (wr == 1) PG8_BAR;
        PG8_WAIT_V(4); PG8_BAR;
        PG8_STAGE(PG8_SB(1, 0), cB + kstep, voffB); PG8_STAGE(PG8_SA(1, 0), cA + kstep, voffA); PG8_STAGE(PG8_SB(1, 1), cB + hstep + kstep, voffB);
        PG8_WAIT_V(6); PG8_BAR;
    }
    for (;;) {
        const bool has_next = S.next(ui + 1, nxt);
        const char* nA = has_next ? (const char*)g.A + (size_t)nxt.pm * tstep : cA; const char* nB = has_next ? (const char*)g.Bt + (size_t)nxt.pn * tstep : cB;
        for (int t = 0; t < nt; t += 2) {
            const bool last = (t == nt - 2);
            const char* a1 = cA + (size_t)(t + 1) * kstep;
            const char* a2 = last ? nA : cA + (size_t)(t + 2) * kstep; const char* b2 = last ? nB : cB + (size_t)(t + 2) * kstep;
            const char* a3 = a2 + kstep; const char* b3 = b2 + kstep;
            if (last && has_next) S.a_ready(nxt);
            if constexpr (SP2) {
            PG8_LDB(B0, 0, 0); PG8_LDB(B1, 0, 1); PG8_SCHED; PG8_LDA(At, 0, 0); PG8_STAGE(PG8_SA(1, 1), a1 + hstep, voffA);
            PG8_WAIT_V(8); PG8_WAIT_L(0); PG8_BAR; PG8_MMA(0, 0, At, B0); PG8_MMA(0, 1, At, B1); PG8_BAR; PG8_SCHED;
            PG8_LDA(At, 0, 1); PG8_STAGE(PG8_SB(0, 0), b2, voffB); PG8_STAGE(PG8_SB(0, 1), b2 + hstep, voffB); PG8_STAGE(PG8_SA(0, 0), a2, voffA);
            PG8_WAIT_V(8); PG8_WAIT_L(0); PG8_BAR; PG8_MMA(1, 0, At, B0); PG8_MMA(1, 1, At, B1); PG8_BAR; PG8_SCHED;
            PG8_LDB(B0, 1, 0); PG8_LDB(B1, 1, 1); PG8_SCHED; PG8_LDA(At, 1, 0); PG8_STAGE(PG8_SA(0, 1), a2 + hstep, voffA);
            PG8_WAIT_V(8); PG8_WAIT_L(0); PG8_BAR; PG8_MMA(0, 0, At, B0); PG8_MMA(0, 1, At, B1); PG8_BAR; PG8_SCHED;
            PG8_LDA(At, 1, 1); PG8_STAGE(PG8_SB(1, 0), b3, voffB); PG8_STAGE(PG8_SB(1, 1), b3 + hstep, voffB); PG8_STAGE(PG8_SA(1, 0), a3, voffA);
            PG8_WAIT_V(8); PG8_WAIT_L(0); PG8_BAR; PG8_MMA(1, 0, At, B0); PG8_MMA(1, 1, At, B1); PG8_BAR; PG8_SCHED;
            } else {
            PG8_LDB(B0, 0, 0); PG8_SCHED; PG8_LDA(At, 0, 0); PG8_STAGE(PG8_SA(1, 1), a1 + hstep, voffA);
            PG8_WAIT_L(8); PG8_BAR; PG8_WAIT_L(0); PG8_MMA(0, 0, At, B0); PG8_BAR; PG8_SCHED;
            PG8_LDB(B1, 0, 1); PG8_STAGE(PG8_SB(0, 0), b2, voffB);
            PG8_BAR; PG8_WAIT_L(0); PG8_MMA(0, 1, At, B1); PG8_BAR;
            PG8_LDA(At, 0, 1); PG8_STAGE(PG8_SA(0, 0), a2, voffA);
            PG8_BAR; PG8_WAIT_L(0); PG8_MMA(1, 0, At, B0); PG8_BAR; PG8_SCHED;
            PG8_STAGE(PG8_SB(0, 1), b2 + hstep, voffB);
            PG8_WAIT_V(6); PG8_BAR; PG8_MMA(1, 1, At, B1); PG8_BAR;
            PG8_LDB(B0, 1, 0); PG8_SCHED; PG8_LDA(At, 1, 0); PG8_STAGE(PG8_SA(0, 1), a2 + hstep, voffA);
            PG8_WAIT_L(8); PG8_BAR; PG8_WAIT_L(0); PG8_MMA(0, 0, At, B0); PG8_BAR; PG8_SCHED;
            PG8_LDB(B1, 1, 1); PG8_STAGE(PG8_SB(1, 0), b3, voffB);
            PG8_BAR; PG8_WAIT_L(0); PG8_MMA(0, 1, At, B1); PG8_BAR;
            PG8_LDA(At, 1, 1); PG8_STAGE(PG8_SA(1, 0), a3, voffA);
            PG8_BAR; PG8_WAIT_L(0); PG8_MMA(1, 0, At, B0); PG8_BAR; PG8_SCHED;
            PG8_STAGE(PG8_SB(1, 1), b3 + hstep, voffB);
            PG8_WAIT_V(6); PG8_BAR; PG8_MMA(1, 1, At, B1); PG8_BAR;
            }
        }
        if constexpr (ALIGN_EPI) { if (wr == 0) PG8_BAR; }
        if constexpr (!Epi::AFTER_DRAIN) { E(acc, cur, wr, wc, fr, fq); S.done(cur); }
        if (!has_next) break;
#pragma unroll
        for (int a = 0; a < 2; ++a)
#pragma unroll
            for (int b = 0; b < 2; ++b)
#pragma unroll
                for (int m = 0; m < 4; ++m)
#pragma unroll
                    for (int n = 0; n < 2; ++n) acc[a][b][m][n] = (f32x4){0.f, 0.f, 0.f, 0.f};
        cur = nxt; cA = nA; cB = nB; ++ui;
        if constexpr (ALIGN_EPI) { if (wr == 1) PG8_BAR; }
    }
    PG8_WAIT_V(0);
    if constexpr (!ALIGN_EPI) { if (wr == 0) PG8_BAR; }
    PG8_BAR;
    if constexpr (Epi::AFTER_DRAIN) { E.fused(acc, cur, wr, wc, fr, fq, lds, wid, lane); S.done(cur); }
#undef PG8_SA
#undef PG8_SB
#undef PG8_STAGE
#undef PG8_LDA
#undef PG8_LDB
#undef PG8_MMA
#undef PG8_WAIT_V
#undef PG8_WAIT_L
#undef PG8_BAR
#undef PG8_SCHED
}
}
namespace pg8 {
__device__ __forceinline__ void load_rstd(const float* ssq, const Unit& u, int wr, int fr, int fq, float (&rs)[2][4]) {
#pragma unroll
    for (int ai = 0; ai < 2; ++ai)
#pragma unroll
        for (int m = 0; m < 4; ++m) {
            const int row = u.pm * BM + ai * HALF + wr * 64 + m * 16 + fr;
            const f32x4 v = *(const f32x4*)(ssq + (size_t)row * 16 + 4 * fq);
            float s = (v[0] + v[1]) + (v[2] + v[3]);
            s += __shfl_xor(s, 16); s += __shfl_xor(s, 32);
            rs[ai][m] = rsqrtf(s * (1.0f / 1024.0f) + 1e-6f);
        }
}
__device__ __forceinline__ float silu_f(float g) { return g * __builtin_amdgcn_rcpf(1.0f + __expf(-g)); }
struct EpiSwiGLU {
    static constexpr bool PERM = true, AFTER_DRAIN = false;
    bf16_t* O; const float* ssq; int ldo;
    __device__ __forceinline__ void operator()(const f32x4 (&acc)[2][2][4][2], const Unit& u, int wr, int wc, int fr, int fq) const {
        float rs[2][4]; load_rstd(ssq, u, wr, fr, fq, rs);
        const int col0 = u.pn * 128 + wc * 32 + 8 * fq;
#pragma unroll
        for (int ai = 0; ai < 2; ++ai)
#pragma unroll
            for (int m = 0; m < 4; ++m) {
                const int row = u.pm * BM + ai * HALF + wr * 64 + m * 16 + fr; const float r = rs[ai][m];
                u32x4 w;
#pragma unroll
                for (int n = 0; n < 2; ++n) {
                    const f32x4 g = acc[ai][0][m][n] * r, uu = acc[ai][1][m][n] * r;
                    const float h0 = silu_f(g[0]) * uu[0], h1 = silu_f(g[1]) * uu[1], h2 = silu_f(g[2]) * uu[2], h3 = silu_f(g[3]) * uu[3];
                    w[2 * n] = cvt_pk_bf16(h0, h1); w[2 * n + 1] = cvt_pk_bf16(h2, h3);
                }
                *(u32x4*)(O + (size_t)row * ldo + col0) = w;
            }
    }
};
struct EpiResid {
    static constexpr bool PERM = true, AFTER_DRAIN = false;
    float* out_final; bf16_t* xb; float* ssq; float alpha;
    __device__ __forceinline__ void operator()(const f32x4 (&acc)[2][2][4][2], const Unit& u, int wr, int wc, int fr, int fq) const {
        const int col0 = u.pn * BM + wc * 32 + 8 * fq;
#pragma unroll
        for (int ai = 0; ai < 2; ++ai)
#pragma unroll
            for (int m = 0; m < 4; ++m) {
                const int row = u.pm * BM + ai * HALF + wr * 64 + m * 16 + fr; float ss = 0.f;
#pragma unroll
                for (int bj = 0; bj < 2; ++bj) {
                    const size_t off = (size_t)row * 1024 + col0 + bj * HALF;
                    const u32x4 xo = *(const u32x4*)(xb + off);
                    f32x4 x0, x1;
                    x0[0] = __builtin_bit_cast(float, xo[0] << 16); x0[1] = __builtin_bit_cast(float, xo[0] & 0xffff0000u); x0[2] = __builtin_bit_cast(float, xo[1] << 16); x0[3] = __builtin_bit_cast(float, xo[1] & 0xffff0000u);
                    x1[0] = __builtin_bit_cast(float, xo[2] << 16); x1[1] = __builtin_bit_cast(float, xo[2] & 0xffff0000u); x1[2] = __builtin_bit_cast(float, xo[3] << 16); x1[3] = __builtin_bit_cast(float, xo[3] & 0xffff0000u);
                    x0 += acc[ai][bj][m][0] * alpha; x1 += acc[ai][bj][m][1] * alpha;
                    if (out_final) { *(f32x4*)(out_final + off) = x0; *(f32x4*)(out_final + off + 4) = x1; }
                    else {
                        u32x4 w; w[0] = cvt_pk_bf16(x0[0], x0[1]); w[1] = cvt_pk_bf16(x0[2], x0[3]); w[2] = cvt_pk_bf16(x1[0], x1[1]); w[3] = cvt_pk_bf16(x1[2], x1[3]);
                        *(u32x4*)(xb + off) = w;
                        ss += (x0[0] * x0[0] + x0[1] * x0[1]) + (x0[2] * x0[2] + x0[3] * x0[3]) + (x1[0] * x1[0] + x1[1] * x1[1]) + (x1[2] * x1[2] + x1[3] * x1[3]);
                    }
                }
                if (!out_final) { ss += __shfl_xor(ss, 16); ss += __shfl_xor(ss, 32);
                    if (fq == 0) ssq[(size_t)row * 16 + u.pn * 4 + wc] = ss; }
            }
    }
};
struct EpiPlain {
    static constexpr bool PERM = true, AFTER_DRAIN = false;
    bf16_t* O; int ldo; int col_off; const float* ssq;
    const float* kn_gain; PG8_LAS float* red;
    __device__ __forceinline__ void operator()(const f32x4 (&acc)[2][2][4][2], const Unit& u, int wr, int wc, int fr, int fq) const {
        float rs[2][4];
        if (ssq) load_rstd(ssq, u, wr, fr, fq, rs);
        if (kn_gain) {
#pragma unroll
            for (int ai = 0; ai < 2; ++ai)
#pragma unroll
                for (int m = 0; m < 4; ++m) { const f32x4 a = acc[ai][0][m][0], b = acc[ai][0][m][1];
                    float ss = (a[0] * a[0] + a[1] * a[1]) + (a[2] * a[2] + a[3] * a[3]) + (b[0] * b[0] + b[1] * b[1]) + (b[2] * b[2] + b[3] * b[3]);
                    ss += __shfl_xor(ss, 16); ss += __shfl_xor(ss, 32);
                    if (fq == 0) red[(ai * HALF + wr * 64 + m * 16 + fr) * 4 + wc] = ss; }
            asm volatile("s_waitcnt lgkmcnt(0)\n\ts_barrier" ::: "memory");
#pragma unroll
            for (int ai = 0; ai < 2; ++ai)
#pragma unroll
                for (int m = 0; m < 4; ++m) { const f32x4 p = *(const PG8_LAS f32x4*)(red + (ai * HALF + wr * 64 + m * 16 + fr) * 4);
                    rs[ai][m] = rsqrtf(((p[0] + p[1]) + (p[2] + p[3])) * (1.0f / 128.0f) + 1e-6f); }
        }
        const int col0 = col_off + u.pn * BM + wc * 32 + 8 * fq;
#pragma unroll
        for (int ai = 0; ai < 2; ++ai)
#pragma unroll
            for (int m = 0; m < 4; ++m) {
                const int row = u.pm * BM + ai * HALF + wr * 64 + m * 16 + fr; const float r = (ssq || kn_gain) ? rs[ai][m] : 1.0f;
#pragma unroll
                for (int bj = 0; bj < 2; ++bj) {
                    f32x4 v0 = acc[ai][bj][m][0], v1 = acc[ai][bj][m][1];
                    if (!kn_gain || bj == 0) { v0 = v0 * r; v1 = v1 * r; }
                    u32x4 w; w[0] = cvt_pk_bf16(v0[0], v0[1]); w[1] = cvt_pk_bf16(v0[2], v0[3]); w[2] = cvt_pk_bf16(v1[0], v1[1]); w[3] = cvt_pk_bf16(v1[2], v1[3]);
                    *(u32x4*)(O + (size_t)row * ldo + col0 + bj * HALF) = w;
                }
            }
    }
};
}
namespace att {
typedef unsigned short bf16_t;
typedef short bf16x8 __attribute__((ext_vector_type(8)));
typedef short s16x4 __attribute__((ext_vector_type(4)));
typedef float f32x16 __attribute__((ext_vector_type(16)));
typedef float f32x4 __attribute__((ext_vector_type(4)));
typedef unsigned u32x4 __attribute__((ext_vector_type(4)));
constexpr int DQK = 192, DV = 128, SEQ = 16384;
constexpr int LDQ = 768, LDK = 1024, LDKR = 64, LDV = 1024, LDO = 1024;
constexpr float SCALE = 0.07216878364870322f;
constexpr float THR = 8.f;
constexpr int NW = 8, QBLK = 32, KVBLK = 64, QB = NW * QBLK;
constexpr int SHM_V = KVBLK * DV * 2, SHM_K = KVBLK * DQK * 2;
constexpr int LDS_BYTES = 2 * SHM_V + 2 * SHM_K + NW * 64 * 4;
#define KSWZ(row, colB) ((row) * 384 + ((colB) ^ ((((row) >> 1) & 7) << 4)))
#define SBAR() __builtin_amdgcn_sched_barrier(0)
__device__ __forceinline__ int v_st(int k, int c) { const int kk = (k & ~0xC) | ((k & 4) << 1) | ((k & 8) >> 1); return ((kk >> 3) * 4 + (c >> 5)) * 512 + ((kk & 7) * 32 + (c & 31)) * 2; }
__device__ __forceinline__ int v_rd_base(int lane) { return ((lane & 3) << 3) | (((lane >> 2) & 3) << 6) | (((lane >> 4) & 1) << 5) | (((lane >> 5) & 1) << 8); }
constexpr int v_rd_off(int d0, int ks, int half) { return d0 * 512 + ks * 4096 + half * 2048; }
__device__ __forceinline__ int crow(int r, int hi) { return (r & 3) + 8 * (r >> 2) + 4 * hi; }
__device__ __forceinline__ unsigned cvtpk(float lo, float hi) { unsigned r; asm volatile("v_cvt_pk_bf16_f32 %0, %1, %2" : "=v"(r) : "v"(lo), "v"(hi)); return r; }
__device__ __forceinline__ bf16x8 load8(const bf16_t* p) { return *reinterpret_cast<const bf16x8*>(p); }
__device__ __forceinline__ void mask_tile(f32x16& p0, f32x16& p1, int dq) {
    const float NEG = -__builtin_inff();
#pragma unroll
    for (int r = 0; r < 16; ++r) {
        const int c = (r & 3) + 8 * (r >> 2);
        if (dq - c < 0) p0[r] = NEG;
        if (dq - c - 32 < 0) p1[r] = NEG;
    }
}
__device__ __forceinline__ void partialSM(f32x16& p0, f32x16& p1, float& m_reg, float& mn, float& alpha) {
    float pmax = p0[0];
#pragma unroll
    for (int r = 1; r < 16; ++r) pmax = fmaxf(pmax, p0[r]);
#pragma unroll
    for (int r = 0; r < 16; ++r) pmax = fmaxf(pmax, p1[r]);
    { auto rr = __builtin_amdgcn_permlane32_swap(__float_as_uint(pmax), __float_as_uint(pmax), false, false);
      pmax = fmaxf(__uint_as_float(rr[0]), __uint_as_float(rr[1])); }
    constexpr float C2 = 1.4426950408889634f * SCALE;
    if (__builtin_expect(__all((pmax - m_reg) * SCALE <= THR), 1)) { mn = m_reg; alpha = 1.f; }
    else { mn = fmaxf(m_reg, pmax); alpha = __builtin_amdgcn_exp2f((m_reg - mn) * C2); m_reg = mn; }
    const float mnL = -mn * C2;
#pragma unroll
    for (int r = 0; r < 16; ++r) p0[r] = fmaf(p0[r], C2, mnL);
#pragma unroll
    for (int r = 0; r < 16; ++r) p1[r] = fmaf(p1[r], C2, mnL);
#pragma unroll
    for (int r = 0; r < 16; ++r) p0[r] = __builtin_amdgcn_exp2f(p0[r]);
}
__device__ __forceinline__ void finishSM(f32x16& p0, f32x16& p1, float alpha, float& l_reg, bf16x8& pa0, bf16x8& pa1, bf16x8& pa2, bf16x8& pa3) {
#pragma unroll
    for (int r = 0; r < 16; ++r) p1[r] = __builtin_amdgcn_exp2f(p1[r]);
    float ps = 0;
#pragma unroll
    for (int r = 0; r < 16; ++r) ps += p0[r];
#pragma unroll
    for (int r = 0; r < 16; ++r) ps += p1[r];
    { auto rr = __builtin_amdgcn_permlane32_swap(__float_as_uint(ps), __float_as_uint(ps), false, false);
      ps = __uint_as_float(rr[0]) + __uint_as_float(rr[1]); }
    l_reg = l_reg * alpha + ps;
#define PK4(P, B_, OUT) do { unsigned a0 = cvtpk(P[B_+0], P[B_+1]), a1 = cvtpk(P[B_+2], P[B_+3]);                          \
        unsigned b0 = cvtpk(P[B_+4], P[B_+5]), b1 = cvtpk(P[B_+6], P[B_+7]);                                             \
        auto r0 = __builtin_amdgcn_permlane32_swap(a0, b0, false, false); auto r1 = __builtin_amdgcn_permlane32_swap(a1, b1, false, false); \
        u32x4 w = {r0[0], r1[0], r0[1], r1[1]}; OUT = *reinterpret_cast<bf16x8*>(&w); } while (0)
    PK4(p0, 0, pa0); PK4(p0, 8, pa1); PK4(p1, 0, pa2); PK4(p1, 8, pa3);
#undef PK4
}
__device__ __forceinline__ void staticSM(f32x16& p0, f32x16& p1, float mB) {
    constexpr float C2 = 1.4426950408889634f * SCALE;
#pragma unroll
    for (int r = 0; r < 16; ++r) p0[r] = __builtin_amdgcn_exp2f(fmaf(p0[r], C2, -mB));
}
template <int KB>
__device__ __forceinline__ void qkt(f32x16& p0, f32x16& p1, const char* K_lds, int r32, int hi, const bf16x8* qr) {
    p0 = f32x16{}; p1 = f32x16{};
    const char* kb[4];
#pragma unroll
    for (int dd = 0; dd < 4; ++dd) kb[dd] = K_lds + KB * SHM_K + KSWZ(r32, (dd * 16 + hi * 8) * 2);
    bf16x8 fa[3], fb[3];
#pragma unroll
    for (int d0 = 0; d0 < 2; ++d0) { const char* a = kb[d0 & 3] + (d0 >> 2) * 128; fa[d0] = *reinterpret_cast<const bf16x8*>(a); fb[d0] = *reinterpret_cast<const bf16x8*>(a + 32 * 384); }
    __builtin_amdgcn_sched_barrier(0);
#pragma unroll
    for (int d0 = 0; d0 < 12; ++d0) {
        if (d0 + 2 < 12) { const char* a = kb[(d0 + 2) & 3] + ((d0 + 2) >> 2) * 128; fa[(d0 + 2) % 3] = *reinterpret_cast<const bf16x8*>(a); fb[(d0 + 2) % 3] = *reinterpret_cast<const bf16x8*>(a + 32 * 384); }
        p0 = __builtin_amdgcn_mfma_f32_32x32x16_bf16(fa[d0 % 3], qr[d0], p0, 0, 0, 0);
        p1 = __builtin_amdgcn_mfma_f32_32x32x16_bf16(fb[d0 % 3], qr[d0], p1, 0, 0, 0);
        __builtin_amdgcn_sched_barrier(0);
    }
}
template <int VB>
__device__ __forceinline__ void pv_tile(f32x16* o, int vb0, bf16x8 pa0, bf16x8 pa1, bf16x8 pa2, bf16x8 pa3) {
#define TRRD(dst, off) asm volatile("ds_read_b64_tr_b16 %0, %1 offset:%2" : "=&v"(dst) : "v"(vb0), "i"(off) : "memory")
#define PV_D0(d0) do { s16x4 l0, l1, l2, l3, h0, h1, h2, h3; constexpr int b_ = VB * SHM_V + v_rd_off(d0, 0, 0);    \
        TRRD(l0, b_); TRRD(h0, b_ + 2048); TRRD(l1, b_ + 4096); TRRD(h1, b_ + 6144); TRRD(l2, b_ + 8192); TRRD(h2, b_ + 10240); TRRD(l3, b_ + 12288); TRRD(h3, b_ + 14336); \
        asm volatile("s_waitcnt lgkmcnt(0)" ::: "memory"); SBAR();                                                   \
        o[d0] = __builtin_amdgcn_mfma_f32_32x32x16_bf16(pa0, (bf16x8){l0[0], l0[1], l0[2], l0[3], h0[0], h0[1], h0[2], h0[3]}, o[d0], 0, 0, 0);   \
        o[d0] = __builtin_amdgcn_mfma_f32_32x32x16_bf16(pa1, (bf16x8){l1[0], l1[1], l1[2], l1[3], h1[0], h1[1], h1[2], h1[3]}, o[d0], 0, 0, 0);   \
        o[d0] = __builtin_amdgcn_mfma_f32_32x32x16_bf16(pa2, (bf16x8){l2[0], l2[1], l2[2], l2[3], h2[0], h2[1], h2[2], h2[3]}, o[d0], 0, 0, 0);   \
        o[d0] = __builtin_amdgcn_mfma_f32_32x32x16_bf16(pa3, (bf16x8){l3[0], l3[1], l3[2], l3[3], h3[0], h3[1], h3[2], h3[3]}, o[d0], 0, 0, 0); } while (0)
    PV_D0(0); PV_D0(1); PV_D0(2); PV_D0(3);
#undef PV_D0
#undef TRRD
}
template <int VB>
__device__ __forceinline__ void pv_tile_pipe(f32x16* o, int vb0, bf16x8 pa0, bf16x8 pa1, bf16x8 pa2, bf16x8 pa3) {
#define TRRD(dst, off) asm volatile("ds_read_b64_tr_b16 %0, %1 offset:%2" : "=&v"(dst) : "v"(vb0), "i"(off) : "memory")
#define PV_RD(S, d0) do { constexpr int b_ = VB * SHM_V + v_rd_off(d0, 0, 0); TRRD(S[0], b_); TRRD(S[1], b_ + 2048); TRRD(S[2], b_ + 4096); TRRD(S[3], b_ + 6144); TRRD(S[4], b_ + 8192); TRRD(S[5], b_ + 10240); TRRD(S[6], b_ + 12288); TRRD(S[7], b_ + 14336); } while (0)
#define PV_MM(S, d0) do {                                                                                                                   \
        o[d0] = __builtin_amdgcn_mfma_f32_32x32x16_bf16(pa0, (bf16x8){S[0][0], S[0][1], S[0][2], S[0][3], S[1][0], S[1][1], S[1][2], S[1][3]}, o[d0], 0, 0, 0);   \
        o[d0] = __builtin_amdgcn_mfma_f32_32x32x16_bf16(pa1, (bf16x8){S[2][0], S[2][1], S[2][2], S[2][3], S[3][0], S[3][1], S[3][2], S[3][3]}, o[d0], 0, 0, 0);   \
        o[d0] = __builtin_amdgcn_mfma_f32_32x32x16_bf16(pa2, (bf16x8){S[4][0], S[4][1], S[4][2], S[4][3], S[5][0], S[5][1], S[5][2], S[5][3]}, o[d0], 0, 0, 0);   \
        o[d0] = __builtin_amdgcn_mfma_f32_32x32x16_bf16(pa3, (bf16x8){S[6][0], S[6][1], S[6][2], S[6][3], S[7][0], S[7][1], S[7][2], S[7][3]}, o[d0], 0, 0, 0); } while (0)
    s16x4 A[8], B[8];
    PV_RD(A, 0); asm volatile("s_waitcnt lgkmcnt(0)" ::: "memory"); SBAR();
    PV_RD(B, 1); SBAR(); PV_MM(A, 0); asm volatile("s_waitcnt lgkmcnt(0)" ::: "memory"); SBAR();
    PV_RD(A, 2); SBAR(); PV_MM(B, 1); asm volatile("s_waitcnt lgkmcnt(0)" ::: "memory"); SBAR();
    PV_RD(B, 3); SBAR(); PV_MM(A, 2); asm volatile("s_waitcnt lgkmcnt(0)" ::: "memory"); SBAR();
    PV_MM(B, 3);
#undef PV_RD
#undef PV_MM
#undef TRRD
}
struct QNorm { const float* gqn; const float* gkn; const float* gqr; const float* rc; const float* rsn; };
__device__ __forceinline__ float bfbits2f(short v) { return __builtin_bit_cast(float, (unsigned)(unsigned short)v << 16); }
__device__ __forceinline__ short f2bfbits(float f) { unsigned u = __builtin_bit_cast(unsigned, f); return (short)((u + 0x7fffu + ((u >> 16) & 1u)) >> 16); }
__device__ __forceinline__ void q_postproc(bf16x8* qr, const QNorm& qn, int tok, int hi) {
    float s1 = 0.f, s2 = 0.f;
#pragma unroll
    for (int d0 = 0; d0 < 12; ++d0)
#pragma unroll
        for (int j = 0; j < 8; ++j) { const float v = bfbits2f(qr[d0][j]); if (d0 < 8) s1 += v * v; else s2 += v * v; }
    { auto rr = __builtin_amdgcn_permlane32_swap(__float_as_uint(s1), __float_as_uint(s1), false, false); s1 = __uint_as_float(rr[0]) + __uint_as_float(rr[1]); }
    { auto rr = __builtin_amdgcn_permlane32_swap(__float_as_uint(s2), __float_as_uint(s2), false, false); s2 = __uint_as_float(rr[0]) + __uint_as_float(rr[1]); }
    const float r1 = rsqrtf(s1 * (1.0f / 128.0f) + 1e-6f), r2 = rsqrtf(s2 * (1.0f / 64.0f) + 1e-6f);
#pragma unroll
    for (int d0 = 0; d0 < 8; ++d0) { const f32x4 g0 = *(const f32x4*)(qn.gqn + 16 * d0 + 8 * hi) * *(const f32x4*)(qn.gkn + 16 * d0 + 8 * hi), g1 = *(const f32x4*)(qn.gqn + 16 * d0 + 8 * hi + 4) * *(const f32x4*)(qn.gkn + 16 * d0 + 8 * hi + 4);
#pragma unroll
        for (int j = 0; j < 8; ++j) qr[d0][j] = f2bfbits(bfbits2f(qr[d0][j]) * r1 * (j < 4 ? g0[j] : g1[j - 4]));
        if (d0 & 1) asm volatile("" ::: "memory"); }
#pragma unroll
    for (int d0 = 8; d0 < 10; ++d0) { const int i0 = 16 * (d0 - 8) + 8 * hi;
        const f32x4 ga0 = *(const f32x4*)(qn.gqr + i0), ga1 = *(const f32x4*)(qn.gqr + i0 + 4), gb0 = *(const f32x4*)(qn.gqr + 32 + i0), gb1 = *(const f32x4*)(qn.gqr + 32 + i0 + 4);
        const f32x4 c0 = *(const f32x4*)(qn.rc + (size_t)tok * 32 + i0), c1 = *(const f32x4*)(qn.rc + (size_t)tok * 32 + i0 + 4), n0 = *(const f32x4*)(qn.rsn + (size_t)tok * 32 + i0), n1 = *(const f32x4*)(qn.rsn + (size_t)tok * 32 + i0 + 4);
#pragma unroll
        for (int j = 0; j < 8; ++j) { const float x1 = bfbits2f(qr[d0][j]) * r2 * (j < 4 ? ga0[j] : ga1[j - 4]), x2 = bfbits2f(qr[d0 + 2][j]) * r2 * (j < 4 ? gb0[j] : gb1[j - 4]);
            const float c = j < 4 ? c0[j] : c1[j - 4], sn = j < 4 ? n0[j] : n1[j - 4];
            qr[d0][j] = f2bfbits(x1 * c - x2 * sn); qr[d0 + 2][j] = f2bfbits(x1 * sn + x2 * c); } }
}
struct BlockRef { const bf16_t* Q; const bf16_t* K; const bf16_t* KR; bf16_t* O; int P0; int tok0; };
#define VMW() asm volatile("s_waitcnt vmcnt(0)" ::: "memory")
struct StReg { bf16x8 v0, v1, k0, k1, k2; };
#define SLOAD_H(S_, k0_) do { S_.v0 = load8(Vh + (size_t)((k0_) + sr) * LDV + sc); S_.v1 = load8(Vh + (size_t)((k0_) + 32 + sr) * LDV + sc);   \
        S_.k0 = load8(Kh + (size_t)((k0_) + kr0) * LDK + kc0); S_.k1 = load8(Kh + (size_t)((k0_) + kr1) * LDK + kc1); S_.k2 = load8(KRh + (size_t)((k0_) + kr2) * LDKR + (kc2 - 128)); } while (0)
#define SWRITE_H(S_, bf) do { *(bf16x8*)(V_lds + (bf) * SHM_V + vst0) = S_.v0; *(bf16x8*)(V_lds + (bf) * SHM_V + vst1) = S_.v1;            \
        *(bf16x8*)(K_lds + (bf) * SHM_K + kws0) = S_.k0; *(bf16x8*)(K_lds + (bf) * SHM_K + kws1) = S_.k1; *(bf16x8*)(K_lds + (bf) * SHM_K + kws2) = S_.k2; } while (0)
template <bool STATIC>
__device__ __forceinline__ void attn_block(const BlockRef& cur, char* lds, float mB, const QNorm& qn) {
    int tid_l = threadIdx.x; asm volatile("" : "+v"(tid_l)); const int tid = tid_l, wid = __builtin_amdgcn_readfirstlane(tid >> 6), lane = tid & 63, r32 = lane & 31, hi = lane >> 5;
    const int NT = (cur.P0 + QB) / KVBLK;
    const int qlo = cur.P0 + wid * QBLK, qm = qlo + r32 - 4 * hi;
    char* V_lds = lds; char* K_lds = lds + 2 * SHM_V;
    float* ws = (float*)(lds + 2 * SHM_V + 2 * SHM_K) + wid * 64; float* li_l = ws, * al_l = ws + 32;
    float m_reg = -1e30f, l_reg = 0; f32x16 o[4] = {};
    const int sr = tid >> 4, sc = (tid & 15) * 8;
    const int kr0 = tid >> 4, kc0 = (tid & 15) * 8, kr1 = kr0 + 32, kc1 = kc0, kr2 = tid >> 3, kc2 = 128 + (tid & 7) * 8;
    const int kws0 = KSWZ(kr0, kc0 * 2), kws1 = KSWZ(kr1, kc1 * 2), kws2 = KSWZ(kr2, kc2 * 2);
    const int vst0 = v_st(sr, sc), vst1 = v_st(32 + sr, sc);
    const int vb0 = (int)(uintptr_t)V_lds + v_rd_base(lane);
    const bf16_t* Kh = cur.K; const bf16_t* KRh = cur.KR; const bf16_t* Vh = cur.K + 128;
    StReg sA;
    bf16x8 qr[12];
#pragma unroll
    for (int d0 = 0; d0 < 12; ++d0) qr[d0] = load8(cur.Q + (size_t)(wid * QBLK + r32) * LDQ + d0 * 16 + hi * 8);
    SLOAD_H(sA, 0); VMW(); SWRITE_H(sA, 0);
    q_postproc(qr, qn, cur.tok0 + wid * QBLK + r32, hi);
    SLOAD_H(sA, KVBLK);
    asm volatile("s_waitcnt lgkmcnt(0)\n\ts_barrier" ::: "memory");
#define RESC(a) do { if (__any((a) < 1.f)) { if (hi == 0) al_l[r32] = (a); asm volatile("s_waitcnt lgkmcnt(0)" ::: "memory");              \
                     _Pragma("unroll") for (int d_ = 0; d_ < 4; ++d_) _Pragma("unroll") for (int r = 0; r < 16; ++r) o[d_][r] *= al_l[crow(r, hi)]; } } while (0)
#define KBASE(t) ((t) * KVBLK)
#define MASKT(P0_, P1_, t) do { const int kb_ = KBASE(t); if (kb_ + KVBLK - 1 > qlo) mask_tile(P0_, P1_, qm - kb_); } while (0)
    f32x16 p0, p1; float mn, al; bf16x8 pa0, pa1, pa2, pa3;
#define STEP(t, BUF, SN, SW) do {                                                                                             \
        SWRITE_H(sA, 1 - BUF);     \
        { const int tn_ = (t) + 2 < NT ? (t) + 2 : NT - 1; SLOAD_H(sA, KBASE(tn_)); }     \
        SBAR(); qkt<BUF>(p0, p1, K_lds, r32, hi, qr);                                                                         \
        MASKT(p0, p1, (t));                                                                                                   \
        if (STATIC) { staticSM(p0, p1, mB); _Pragma("unroll") for (int r_ = 0; r_ < 16; ++r_) p1[r_] = fmaf(p1[r_], 1.4426950408889634f * SCALE, -mB); finishSM(p0, p1, 1.0f, l_reg, pa0, pa1, pa2, pa3); } \
        else { partialSM(p0, p1, m_reg, mn, al); finishSM(p0, p1, al, l_reg, pa0, pa1, pa2, pa3); RESC(al); } SBAR();       \
        if (STATIC) pv_tile_pipe<BUF>(o, vb0, pa0, pa1, pa2, pa3); else pv_tile<BUF>(o, vb0, pa0, pa1, pa2, pa3);             \
        asm volatile("s_waitcnt lgkmcnt(0)\n\ts_barrier" ::: "memory"); } while (0)
    for (int t = 0; t < NT; t += 2) { STEP(t, 0, sA, sA); STEP(t + 1, 1, sA, sA); }
    if (hi == 0) li_l[r32] = l_reg; asm volatile("s_waitcnt lgkmcnt(0)" ::: "memory");
    float rli[16];
#pragma unroll
    for (int r = 0; r < 16; ++r) rli[r] = __builtin_amdgcn_rcpf(li_l[crow(r, hi)]);
    bf16_t* Ow = cur.O + (size_t)(wid * QBLK) * LDO;
#pragma unroll
    for (int r = 0; r < 16; ++r) { const int orow = crow(r, hi);
#pragma unroll
        for (int d0 = 0; d0 < 4; ++d0) { const float v = o[d0][r] * rli[r];
            const float vn = __shfl_xor(v, 1);
            if ((r32 & 1) == 0) *(unsigned*)(Ow + (size_t)orow * LDO + d0 * 32 + r32) = cvtpk(v, vn); } }
    __syncthreads();
#undef RESC
#undef KBASE
#undef MASKT
#undef STEP
}
#undef VMW
#undef SLOAD_H
#undef SWRITE_H
#undef SBAR
}
#define LAS __attribute__((address_space(3)))
typedef unsigned short bf16;
typedef float f32x4 __attribute__((ext_vector_type(4)));
typedef float f32x2 __attribute__((ext_vector_type(2)));
typedef float f32x16 __attribute__((ext_vector_type(16)));
typedef unsigned u32x4 __attribute__((ext_vector_type(4)));
typedef unsigned u32x2 __attribute__((ext_vector_type(2)));
typedef short bf16x8 __attribute__((ext_vector_type(8)));
typedef short s16x4 __attribute__((ext_vector_type(4)));
#ifndef PROBE_ATTN
#define PROBE_ATTN 0
#endif
#ifndef PROBE_FFNUP
#define PROBE_FFNUP 0
#endif
#ifndef PROBE_REP
#define PROBE_REP 0
#endif
#ifndef PROBE_SYNC
#define PROBE_SYNC 0
#endif
#ifndef PROBE_CO
#define PROBE_CO 0
#endif
#ifndef ONE_LAUNCH
#define ONE_LAUNCH 1
#endif
constexpr int NB = 2, SEQ = 16384, M = NB * SEQ, D = 1024, DFF = 2816, INC = 2768, INP = 2816, MIXK = 1024, NCHUNK = SEQ / 128;
constexpr float EPS = 1e-6f;
constexpr int NTHREADS = 512, LDS_BYTES = 147456;
constexpr int PH_PER_LAYER = 11, NPHASE = 2 * PH_PER_LAYER;
constexpr size_t MiB = 1u << 20;
constexpr size_t WS_W1 = 0;
constexpr size_t WS_W2 = WS_W1 + (size_t)5632 * 1024 * 2;
constexpr size_t WS_WIN = WS_W2 + (size_t)1024 * 2816 * 2;
constexpr size_t WS_WUQ = WS_WIN + (size_t)2816 * 1024 * 2;
constexpr size_t WS_WUKV = WS_WUQ + (size_t)768 * 384 * 2;
constexpr size_t WS_WOUT = WS_WUKV + (size_t)1024 * 256 * 2;
constexpr size_t WS_W3 = WS_WOUT + (size_t)1024 * 1280 * 2;
constexpr size_t WS_W4 = WS_W3 + (size_t)5632 * 1024 * 2;
constexpr size_t WS_WEND = WS_W4 + (size_t)1024 * 2816 * 2;
constexpr size_t WS_XB = 44 * MiB;
constexpr size_t OUT_KV = 0, OUT_QF = 64 * MiB;
constexpr size_t WS_A = WS_XB + 64 * MiB;
constexpr size_t WS_B = WS_A + 176 * MiB;
constexpr size_t WS_LOGA = WS_B, WS_URET = WS_B + 32 * MiB, WS_UGLA = WS_B + 48 * MiB, WS_GDEC = WS_B + 64 * MiB, WS_CQN = WS_B + 65 * MiB, WS_CKVN = WS_B + 89 * MiB, WS_KROPE = WS_B + 105 * MiB;
constexpr size_t WS_MIX = WS_B + 110 * MiB;
constexpr size_t WS_SSQ = WS_MIX + 64 * MiB;
constexpr size_t WS_ROPE = WS_SSQ + 2 * MiB;
constexpr size_t WS_CTL = WS_ROPE + 8 * MiB, CTL_BYTES = 16384;
constexpr size_t WS_END = WS_CTL + 1 * MiB;
static_assert(WS_WEND <= WS_XB && (size_t)M * 2816 * 2 <= 176 * MiB && WS_END <= 512 * MiB, "d_ws map");

__constant__ double INVF[32] = {1.0, 0.7498942093324559, 0.5623413251903491, 0.4216965034285822, 0.31622776601683794, 0.23713737056616552, 0.1778279410038923, 0.1333521432163324, 0.1, 0.07498942093324558, 0.05623413251903491, 0.042169650342858224, 0.03162277660168379, 0.023713737056616554, 0.01778279410038923, 0.01333521432163324, 0.01, 0.007498942093324558, 0.005623413251903491, 0.004216965034285823, 0.0031622776601683794, 0.0023713737056616554, 0.0017782794100389228, 0.001333521432163324, 0.001, 0.0007498942093324559, 0.0005623413251903491, 0.00042169650342858224, 0.00031622776601683794, 0.00023713737056616554, 0.00017782794100389227, 0.0001333521432163324};
__device__ __forceinline__ float ret_log2g(int h) { return h == 0 ? -0.04580368961312479f : h == 1 ? -0.02272007650008353f : h == 2 ? -0.011315313227834146f : -0.005646563141142063f; }

__device__ __forceinline__ unsigned f2bf(float f) { unsigned u = __builtin_bit_cast(unsigned, f); return (u + 0x7fffu + ((u >> 16) & 1u)) >> 16; }
__device__ __forceinline__ unsigned pk2(float lo, float hi) { return f2bf(lo) | (f2bf(hi) << 16); }
__device__ __forceinline__ float bflo(unsigned w) { return __builtin_bit_cast(float, w << 16); }
__device__ __forceinline__ float bfhi(unsigned w) { return __builtin_bit_cast(float, w & 0xffff0000u); }
__device__ __forceinline__ float bf2f(bf16 v) { return __builtin_bit_cast(float, (unsigned)v << 16); }
__device__ __forceinline__ float wave_sum(float v) {
#pragma unroll
    for (int o = 1; o < 64; o <<= 1) v += __shfl_xor(v, o);
    return v;
}
__device__ __forceinline__ float silu(float g) { return g * __builtin_amdgcn_rcpf(1.0f + __expf(-g)); }
#define MFMA32(a, b, c) __builtin_amdgcn_mfma_f32_32x32x16_bf16((a), (b), (c), 0, 0, 0)
__device__ __forceinline__ int crow(int r, int hi) { return (r & 3) + 8 * (r >> 2) + 4 * hi; }

struct Params { const float* in[23]; float* out; unsigned char* ws; int ph_lo, ph_hi; };
struct Frame {
    unsigned char* lds; int tid, lane, wave, G, bid;
    const float* in[23]; float* out; unsigned char* ws;
};

struct TrDesc { const float* W; const float* gain; bf16* WT; int ldw, ldt, k0, kdst0, scol0, nvalid, drow0; };
__device__ __forceinline__ void tr_load(const TrDesc& d, f32x4 (&v)[16], int lane) {
    const int nq = (lane & 15) * 4, kq = lane >> 4;
#pragma unroll
    for (int j = 0; j < 16; ++j) { const int kk = 8 * (j >> 1) + 2 * kq + (j & 1);
        v[j] = (f32x4){0.f, 0.f, 0.f, 0.f};
        if (nq < d.nvalid) v[j] = *(const f32x4*)(d.W + (size_t)(d.k0 + kk) * d.ldw + d.scol0 + nq); }
}
__device__ __forceinline__ void tr_store(const TrDesc& d, f32x4 (&v)[16], unsigned* scr, int lane) {
    const int nq = (lane & 15) * 4, kq = lane >> 4;
    if (d.gain) {
#pragma unroll
        for (int j = 0; j < 16; ++j) { const int kk = 8 * (j >> 1) + 2 * kq + (j & 1); v[j] *= d.gain[d.k0 + kk]; } }
#pragma unroll
    for (int m = 0; m < 8; ++m) { const int kp = 4 * m + kq;
#pragma unroll
        for (int c = 0; c < 4; ++c) scr[(nq + c) * 33 + kp] = pk2(v[2 * m][c], v[2 * m + 1][c]); }
    asm volatile("s_waitcnt lgkmcnt(0)" ::: "memory");
    const int cc = lane & 7;
#pragma unroll
    for (int r = 0; r < 8; ++r) { const int n = 8 * r + (lane >> 3); const unsigned* s = scr + n * 33 + 4 * cc;
        u32x4 o; o[0] = s[0]; o[1] = s[1]; o[2] = s[2]; o[3] = s[3];
        *(u32x4*)(d.WT + (size_t)(d.drow0 + n) * d.ldt + d.kdst0 + 8 * cc) = o; }
    asm volatile("s_waitcnt lgkmcnt(0)" ::: "memory");
}
constexpr int PI1 = 88 * 16, PI2 = 16 * 44, PI3 = 44 * 16, PI4 = 12 * 6, PI5 = 16 * 4, PI6 = 16 * 16;
constexpr int PNITEMS = 2 * PI1 + 2 * PI2 + PI3 + PI4 + PI5 + PI6;
__device__ __forceinline__ TrDesc tr_decode(Frame& F, int l, int it) {
    unsigned char* ws = F.ws; TrDesc d; int r = it;
    if (r < 2 * PI1) {
        const int which = r / PI1; r -= which * PI1; const int db = r / 16, kb = r % 16, pn = db >> 2, bj = (db >> 1) & 1, i64 = db & 1;
        d.W = (which ? F.in[21] : F.in[3]) + (size_t)l * 1024 * 5632; d.gain = (which ? F.in[20] : F.in[2]) + l * 1024; d.WT = (bf16*)(ws + (which ? WS_W3 : WS_W1));
        d.ldw = 5632; d.ldt = 1024; d.k0 = kb * 64; d.kdst0 = kb * 64; d.scol0 = bj * 2816 + pn * 128 + i64 * 64; d.nvalid = 64; d.drow0 = db * 64; return d; }
    r -= 2 * PI1;
    if (r < 2 * PI2) {
        const int which = r / PI2; r -= which * PI2; const int db = r / 44, kb = r % 44;
        d.W = (which ? F.in[22] : F.in[4]) + (size_t)l * 2816 * 1024; d.gain = nullptr; d.WT = (bf16*)(ws + (which ? WS_W4 : WS_W2));
        d.ldw = 1024; d.ldt = 2816; d.k0 = kb * 64; d.kdst0 = kb * 64; d.scol0 = db * 64; d.nvalid = 64; d.drow0 = db * 64; return d; }
    r -= 2 * PI2;
    if (r < PI3) {
        const int db = r / 16, kb = r % 16; int nv = INC - db * 64; nv = nv < 0 ? 0 : (nv > 64 ? 64 : nv);
        d.W = F.in[6] + (size_t)l * 1024 * INC; d.gain = F.in[5] + l * 1024; d.WT = (bf16*)(ws + WS_WIN);
        d.ldw = INC; d.ldt = 1024; d.k0 = kb * 64; d.kdst0 = kb * 64; d.scol0 = db * 64; d.nvalid = nv; d.drow0 = db * 64; return d; }
    r -= PI3;
    if (r < PI4) { const int db = r / 6, kb = r % 6;
        d.W = F.in[9] + (size_t)l * 384 * 768; d.gain = nullptr; d.WT = (bf16*)(ws + WS_WUQ);
        d.ldw = 768; d.ldt = 384; d.k0 = kb * 64; d.kdst0 = kb * 64; d.scol0 = db * 64; d.nvalid = 64; d.drow0 = db * 64; return d; }
    r -= PI4;
    if (r < PI5) { const int db = r / 4, kb = r % 4;
        d.W = F.in[11] + (size_t)l * 256 * 1024; d.gain = nullptr; d.WT = (bf16*)(ws + WS_WUKV);
        d.ldw = 1024; d.ldt = 256; d.k0 = kb * 64; d.kdst0 = kb * 64; d.scol0 = db * 64; d.nvalid = 64; d.drow0 = db * 64; return d; }
    r -= PI5;
    { const int db = r / 16, kb = r % 16;
        d.W = F.in[19] + (size_t)l * 1024 * 1024; d.gain = nullptr; d.WT = (bf16*)(ws + WS_WOUT);
        d.ldw = 1024; d.ldt = MIXK; d.k0 = kb * 64; d.kdst0 = kb * 64; d.scol0 = db * 64; d.nvalid = 64; d.drow0 = db * 64; return d; }
}
__device__ __forceinline__ void prep_phase(Frame& F, int l) {
    unsigned* scr = (unsigned*)(F.lds + F.wave * 8448);
    const int gw = F.bid * 8 + F.wave, NGW = F.G * 8;
    unsigned char* ws = F.ws;
    if (gw < PNITEMS) {
        f32x4 va[16], vb[16];
        TrDesc da = tr_decode(F, l, gw), db_; tr_load(da, va, F.lane);
        for (int it = gw; it < PNITEMS; it += 2 * NGW) {
            const int i1 = it + NGW, i2 = it + 2 * NGW;
            if (i1 < PNITEMS) { db_ = tr_decode(F, l, i1); tr_load(db_, vb, F.lane); }
            tr_store(da, va, scr, F.lane);
            if (i1 < PNITEMS) {
                if (i2 < PNITEMS) { da = tr_decode(F, l, i2); tr_load(da, va, F.lane); }
                tr_store(db_, vb, scr, F.lane);
            }
        }
    }
    if (l == 0) {
        const float* x = F.in[0]; bf16* xb = (bf16*)(ws + WS_XB); float* ssq = (float*)(ws + WS_SSQ);
        for (int m = gw; m < M; m += NGW) {
            const f32x4* xr = (const f32x4*)(x + (size_t)m * D) + F.lane; float s = 0.f;
            u32x2* o8 = (u32x2*)(xb + (size_t)m * D) + F.lane;
#pragma unroll
            for (int j = 0; j < 4; ++j) { const f32x4 v = xr[64 * j]; s += (v[0] * v[0] + v[1] * v[1]) + (v[2] * v[2] + v[3] * v[3]);
                u32x2 w; w[0] = pk2(v[0], v[1]); w[1] = pk2(v[2], v[3]); o8[64 * j] = w; }
            s = wave_sum(s);
            if (F.lane < 16) ssq[(size_t)m * 16 + F.lane] = F.lane == 0 ? s : 0.f;
        }
        const int* pos = (const int*)F.in[1]; float* rc = (float*)(ws + WS_ROPE); float* rsn = rc + (size_t)M * 32;
        for (int e = F.bid * NTHREADS + F.tid; e < M * 32; e += F.G * NTHREADS) {
            const int tok = e >> 5, i = e & 31;
            const double ang = (double)pos[tok] * INVF[i]; double rev = ang * 0.15915494309189535; rev -= __builtin_floor(rev);
            const float rf = (float)rev;
            rc[e] = __builtin_amdgcn_cosf(rf); rsn[e] = __builtin_amdgcn_sinf(rf);
        }
    }
}

struct P1Tok { unsigned cq[3]; u32x2 ckv; u32x4 al0, al1; float c1, s1; bf16 kr; };
__device__ __forceinline__ P1Tok p1_load(const bf16* proj, const float* rc, const float* rsn, int tok, int lane) {
    P1Tok t; const bf16* p = proj + (size_t)tok * INP;
#pragma unroll
    for (int j = 0; j < 3; ++j) t.cq[j] = *(const unsigned*)(p + 1024 + 128 * j + 2 * lane);
    t.ckv = *(const u32x2*)(p + 1408 + 4 * lane); t.kr = p[1664 + lane];
    t.al0 = *(const u32x4*)(p + 2496); t.al1 = *(const u32x4*)(p + 2504);
    t.c1 = rc[(size_t)tok * 32 + (lane & 31)]; t.s1 = rsn[(size_t)tok * 32 + (lane & 31)];
    return t;
}
__device__ __forceinline__ void post1_phase(Frame& F, int l) {
    unsigned char* ws = F.ws; const int lane = F.lane;
    const bf16* proj = (const bf16*)(ws + WS_A);
    bf16 *cqn = (bf16*)(ws + WS_CQN), *ckvn = (bf16*)(ws + WS_CKVN), *krope = (bf16*)(ws + WS_KROPE);
    float* loga = (float*)(ws + WS_LOGA);
    const float* rc = (const float*)(ws + WS_ROPE); const float* rsn = rc + (size_t)M * 32;
    const float* g_q = F.in[8] + l * 384; const float* g_kv = F.in[10] + l * 256; const float* g_kr = F.in[15] + l * 64;
    const float* Wg = F.in[16] + (size_t)l * 16 * 256; const float* bg = F.in[17] + l * 256;
    const int gw = F.bid * 8 + F.wave, NGW = F.G * 8;
    f32x4 wgr[16];
#pragma unroll
    for (int r = 0; r < 16; ++r) wgr[r] = *(const f32x4*)(Wg + r * 256 + 4 * lane);
    const f32x4 bias = *(const f32x4*)(bg + 4 * lane), gkv = *(const f32x4*)(g_kv + 4 * lane);
    float gq[6];
#pragma unroll
    for (int j = 0; j < 3; ++j) { gq[2 * j] = g_q[128 * j + 2 * lane]; gq[2 * j + 1] = g_q[128 * j + 2 * lane + 1]; }
    const float gkr = g_kr[lane];
    if (gw >= M) return;
    P1Tok t = p1_load(proj, rc, rsn, gw, lane);
    for (int tok = gw; tok < M; tok += NGW) {
        const int tn = tok + NGW < M ? tok + NGW : tok;
        const P1Tok nx = p1_load(proj, rc, rsn, tn, lane);
        float ssq_ = 0.f;
#pragma unroll
        for (int j = 0; j < 3; ++j) { const float x0 = bflo(t.cq[j]), x1 = bfhi(t.cq[j]); ssq_ += x0 * x0 + x1 * x1; }
        const float k0 = bflo(t.ckv[0]), k1 = bfhi(t.ckv[0]), k2 = bflo(t.ckv[1]), k3 = bfhi(t.ckv[1]);
        float sskv = (k0 * k0 + k1 * k1) + (k2 * k2 + k3 * k3);
        const float v = bf2f(t.kr); float sskr = v * v;
#pragma unroll
        for (int o = 1; o < 64; o <<= 1) { ssq_ += __shfl_xor(ssq_, o); sskv += __shfl_xor(sskv, o); sskr += __shfl_xor(sskr, o); }
        { const float r = rsqrtf(ssq_ * (1.0f / 384.0f) + EPS);
#pragma unroll
          for (int j = 0; j < 3; ++j) *(unsigned*)(cqn + (size_t)tok * 384 + 128 * j + 2 * lane) = pk2(bflo(t.cq[j]) * r * gq[2 * j], bfhi(t.cq[j]) * r * gq[2 * j + 1]); }
        { const float r = rsqrtf(sskv * (1.0f / 256.0f) + EPS); u32x2 o; o[0] = pk2(k0 * r * gkv[0], k1 * r * gkv[1]); o[1] = pk2(k2 * r * gkv[2], k3 * r * gkv[3]);
          *(u32x2*)(ckvn + (size_t)tok * 256 + 4 * lane) = o; }
        { const float r = rsqrtf(sskr * (1.0f / 64.0f) + EPS); const float vn = v * r * gkr; const float other = __shfl_xor(vn, 32);
          const float o = lane < 32 ? vn * t.c1 - other * t.s1 : other * t.s1 + vn * t.c1; krope[(size_t)tok * 64 + lane] = (bf16)f2bf(o); }
        {
            float al[16];
#pragma unroll
            for (int j = 0; j < 4; ++j) { al[2 * j] = bflo(t.al0[j]); al[2 * j + 1] = bfhi(t.al0[j]); al[8 + 2 * j] = bflo(t.al1[j]); al[9 + 2 * j] = bfhi(t.al1[j]); }
            f32x4 x = bias;
#pragma unroll
            for (int r = 0; r < 16; ++r) x += wgr[r] * al[r];
            f32x4 o;
#pragma unroll
            for (int j = 0; j < 4; ++j) { const float xv = x[j]; o[j] = (fminf(xv, 0.f) - __logf(1.0f + __expf(-fabsf(xv)))) * (1.0f / 16.0f); }
            *(f32x4*)(loga + (size_t)tok * 256 + 4 * lane) = o;
        }
        t = nx;
    }
}

struct P2Tok { unsigned ka[4]; };
__device__ __forceinline__ P2Tok p2_load(const bf16* kv, int tok, int lane) {
    P2Tok t; const bf16* kvp = kv + (size_t)tok * 1024;
#pragma unroll
    for (int h = 0; h < 4; ++h) t.ka[h] = *(const unsigned*)(kvp + h * 256 + 2 * lane);
    return t;
}
__device__ __forceinline__ void post2_phase(Frame& F, int l) {
    const int lane = F.lane;
    bf16* kv = (bf16*)((unsigned char*)F.out + OUT_KV);
    const float* g_kn = F.in[14] + l * 128;
    const int gw = F.bid * 8 + F.wave, NGW = F.G * 8;
    const float gk0 = g_kn[2 * lane], gk1 = g_kn[2 * lane + 1];
    if (gw >= M) return;
    P2Tok t = p2_load(kv, gw, lane);
    for (int tok = gw; tok < M; tok += NGW) {
        const int tn = tok + NGW < M ? tok + NGW : tok;
        const P2Tok nx = p2_load(kv, tn, lane);
        bf16* kd = kv + (size_t)tok * 1024;
        float s3[4];
#pragma unroll
        for (int h = 0; h < 4; ++h) { const float k0 = bflo(t.ka[h]), k1 = bfhi(t.ka[h]); s3[h] = k0 * k0 + k1 * k1; }
#pragma unroll
        for (int o = 1; o < 64; o <<= 1)
#pragma unroll
            for (int h = 0; h < 4; ++h) s3[h] += __shfl_xor(s3[h], o);
#pragma unroll
        for (int h = 0; h < 4; ++h) { const float k0 = bflo(t.ka[h]), k1 = bfhi(t.ka[h]); const float r3 = rsqrtf(s3[h] * (1.0f / 128.0f) + EPS);
            *(unsigned*)(kd + h * 256 + 2 * lane) = pk2(k0 * r3 * gk0, k1 * r3 * gk1); }
        t = nx;
    }
}
constexpr int LQ = 72, LT = 136, LB = 65;
__device__ __forceinline__ void gla_cumsum_regs(const f32x4 (&la)[4], float* Bc, int tid) {
#pragma unroll
    for (int i = 0; i < 4; ++i) { const int idx = tid + 512 * i, t = idx >> 4, c4 = (idx & 15) * 4;
        Bc[t * LB + c4] = la[i][0]; Bc[t * LB + c4 + 1] = la[i][1]; Bc[t * LB + c4 + 2] = la[i][2]; Bc[t * LB + c4 + 3] = la[i][3]; }
    __syncthreads();
    const int d = tid & 63, seg = tid >> 6; float run = 0.f;
#pragma unroll
    for (int j = 0; j < 16; ++j) { run += Bc[(16 * seg + j) * LB + d]; Bc[(16 * seg + j) * LB + d] = run; }
    __syncthreads();
    float off = 0.f;
    for (int s2 = 0; s2 < seg; ++s2) off += Bc[(16 * s2 + 15) * LB + d];
    __syncthreads();
#pragma unroll
    for (int j = 0; j < 16; ++j) Bc[(16 * seg + j) * LB + d] += off;
    __syncthreads();
}
struct CsRegs { bf16x8 k[2], v[2]; f32x4 la[4]; };
__device__ __forceinline__ void cs_load(CsRegs& R, unsigned char* ws, int it, int tid) {
    const bool gla = it >= 1024; const int ch = it & 1023, b = ch >> 9, h = (ch >> 7) & 3, n = ch & 127, t0 = b * SEQ + n * 128;
    const bf16* proj = (const bf16*)(ws + WS_A); const int koff = (gla ? 1984 : 256) + h * 64, voff = (gla ? 2240 : 512) + h * 64;
    const int s = tid & 127, cq = (tid >> 7) * 8; const bf16* row = proj + (size_t)(t0 + s) * INP;
    R.k[0] = *(const bf16x8*)(row + koff + cq); R.k[1] = *(const bf16x8*)(row + koff + 32 + cq);
    R.v[0] = *(const bf16x8*)(row + voff + cq); R.v[1] = *(const bf16x8*)(row + voff + 32 + cq);
    if (gla) { const float* loga = (const float*)(ws + WS_LOGA);
#pragma unroll
        for (int i = 0; i < 4; ++i) { const int idx = tid + 512 * i, t = idx >> 4, c4 = (idx & 15) * 4; R.la[i] = *(const f32x4*)(loga + (size_t)(t0 + t) * 256 + h * 64 + c4); } }
    else { const float* rc = (const float*)(ws + WS_ROPE) + (size_t)(t0 + s) * 32 + cq; const float* rsn = rc + (size_t)M * 32;
        R.la[0] = *(const f32x4*)rc; R.la[1] = *(const f32x4*)(rc + 4); R.la[2] = *(const f32x4*)rsn; R.la[3] = *(const f32x4*)(rsn + 4); }
}
__device__ __forceinline__ void chunk_state_phase(Frame& F) {
    unsigned char* ws = F.ws;
    bf16* Vt = (bf16*)F.lds; bf16* Kt = (bf16*)(F.lds + 17408); float* Bc = (float*)(F.lds + 34816);
    float* gdec = (float*)(ws + WS_GDEC);
    int it = F.bid; if (it >= 2048) return;
    CsRegs R; cs_load(R, ws, it, F.tid);
    for (; it < 2048; it += F.G) {
        int tid = F.tid; asm volatile("" : "+v"(tid)); const int lane = tid & 63, r32 = lane & 31, hi = lane >> 5;
        const bool gla = it >= 1024; const int ch = it & 1023, h = (ch >> 7) & 3;
        float* U = (float*)(ws + (gla ? WS_UGLA : WS_URET));
        if (gla) gla_cumsum_regs(R.la, Bc, tid);
        const float l2g = ret_log2g(h);
        { const int s = tid & 127, cq = (tid >> 7) * 8;
            const float zr = __builtin_amdgcn_exp2f((float)(127 - s) * l2g) * 0.125f;
#pragma unroll
            for (int j = 0; j < 8; ++j) { Vt[(cq + j) * LT + s] = (bf16)R.v[0][j]; Vt[(32 + cq + j) * LT + s] = (bf16)R.v[1][j];
                const float x1 = bf2f((bf16)R.k[0][j]), x2 = bf2f((bf16)R.k[1][j]); float k1, k2;
                if (gla) { k1 = x1 * __expf(Bc[127 * LB + cq + j] - Bc[s * LB + cq + j]); k2 = x2 * __expf(Bc[127 * LB + 32 + cq + j] - Bc[s * LB + 32 + cq + j]); }
                else { const float cc = R.la[j >> 2][j & 3], sn = R.la[2 + (j >> 2)][j & 3]; k1 = (x1 * cc - x2 * sn) * zr; k2 = (x1 * sn + x2 * cc) * zr; }
                Kt[(cq + j) * LT + s] = (bf16)f2bf(k1); Kt[(32 + cq + j) * LT + s] = (bf16)f2bf(k2); } }
        __syncthreads();
        if (it + F.G < 2048) cs_load(R, ws, it + F.G, tid);
        if (F.wave < 4) { const int vt = F.wave >> 1, dt = F.wave & 1; f32x16 acc = {};
#pragma unroll
            for (int ks = 0; ks < 8; ++ks) { const bf16x8 a = *(const bf16x8*)(Vt + (32 * vt + r32) * LT + 16 * ks + 8 * hi), bb = *(const bf16x8*)(Kt + (32 * dt + r32) * LT + 16 * ks + 8 * hi);
                acc = MFMA32(a, bb, acc); }
#pragma unroll
            for (int r = 0; r < 16; ++r) U[(size_t)ch * 4096 + (32 * vt + crow(r, hi)) * 64 + 32 * dt + r32] = acc[r];
        }
        if (gla && tid < 64) gdec[ch * 64 + tid] = __expf(Bc[127 * LB + tid]);
        __syncthreads();
    }
}
__device__ __forceinline__ void scan_phase(Frame& F) {
    unsigned char* ws = F.ws; const float* gdec = (const float*)(ws + WS_GDEC);
    float* sumD = (float*)F.lds; float* sumE = sumD + 512;
    const int tid = F.tid, g = tid >> 6, el = tid & 63;
    for (int blk = F.bid; blk < 1024; blk += F.G) {
        const int type = blk >> 9, bh = (blk >> 6) & 7, e = (blk & 63) * 64 + el;
        float* U = (float*)(ws + (type ? WS_UGLA : WS_URET)) + (size_t)(bh * 128 + 16 * g) * 4096 + e;
        const float dret = __builtin_amdgcn_exp2f(128.0f * ret_log2g(bh & 3));
        float u[16], dc[16];
#pragma unroll
        for (int j = 0; j < 16; ++j) { u[j] = U[(size_t)j * 4096]; dc[j] = type ? gdec[(bh * 128 + 16 * g + j) * 64 + (e & 63)] : dret; }
        float D = 1.f, E = 0.f;
#pragma unroll
        for (int j = 0; j < 16; ++j) { E = E * dc[j] + u[j]; D *= dc[j]; }
        sumD[tid] = D; sumE[tid] = E;
        __syncthreads();
        float cur = 0.f;
        for (int g2 = 0; g2 < g; ++g2) cur = cur * sumD[g2 * 64 + el] + sumE[g2 * 64 + el];
#pragma unroll
        for (int j = 0; j < 16; ++j) { U[(size_t)j * 4096] = cur; cur = cur * dc[j] + u[j]; }
        __syncthreads();
    }
}
struct CoRegs { bf16x8 q[2], k[2], v[2]; f32x4 u[2]; f32x4 la[4]; };
__device__ __forceinline__ void co_load(CoRegs& R, unsigned char* ws, int it, int tid) {
    const bool gla = it >= 1024; const int ch = it & 1023, b = ch >> 9, h = (ch >> 7) & 3, n = ch & 127, t0 = b * SEQ + n * 128;
    const bf16* proj = (const bf16*)(ws + WS_A);
    const int qoff = (gla ? 1728 : 0) + h * 64, koff = (gla ? 1984 : 256) + h * 64, voff = (gla ? 2240 : 512) + h * 64;
    const float* U = (const float*)(ws + (gla ? WS_UGLA : WS_URET));
    { const int t = tid >> 2, cq = (tid & 3) * 8; const bf16* row = proj + (size_t)(t0 + t) * INP;
      R.q[0] = *(const bf16x8*)(row + qoff + cq); R.q[1] = *(const bf16x8*)(row + qoff + 32 + cq); R.k[0] = *(const bf16x8*)(row + koff + cq); R.k[1] = *(const bf16x8*)(row + koff + 32 + cq);
      if (!gla) { const float* rc = (const float*)(ws + WS_ROPE) + (size_t)(t0 + t) * 32 + cq; const float* rsn = rc + (size_t)M * 32;
          R.la[0] = *(const f32x4*)rc; R.la[1] = *(const f32x4*)(rc + 4); R.la[2] = *(const f32x4*)rsn; R.la[3] = *(const f32x4*)(rsn + 4); } }
    { const int s = tid & 127, cv = (tid >> 7) * 8; const bf16* row = proj + (size_t)(t0 + s) * INP; R.v[0] = *(const bf16x8*)(row + voff + cv); R.v[1] = *(const bf16x8*)(row + voff + 32 + cv); }
#pragma unroll
    for (int i = 0; i < 2; ++i) { const int idx = tid + 512 * i, v = idx >> 4, c4 = (idx & 15) * 4; R.u[i] = *(const f32x4*)(U + (size_t)ch * 4096 + v * 64 + c4); }
    if (gla) { const float* loga = (const float*)(ws + WS_LOGA);
#pragma unroll
        for (int i = 0; i < 4; ++i) { const int idx = tid + 512 * i, t = idx >> 4, c4 = (idx & 15) * 4; R.la[i] = *(const f32x4*)(loga + (size_t)(t0 + t) * 256 + h * 64 + c4); } }
}
__device__ __forceinline__ void chunk_out_phase(Frame& F, int l) {
    unsigned char* ws = F.ws;
    bf16* Qs = (bf16*)F.lds; bf16* Ks = (bf16*)(F.lds + 18432); bf16* Vt = (bf16*)(F.lds + 36864); bf16* St = (bf16*)(F.lds + 54272); bf16* Q2 = (bf16*)(F.lds + 63488); float* Bc = (float*)(F.lds + 81920);
    bf16* mix = (bf16*)(ws + WS_MIX); const bf16* proj = (const bf16*)(ws + WS_A);
    int it = F.bid; if (it >= 2048) return;
    CoRegs R; co_load(R, ws, it, F.tid);
    for (; it < 2048; it += F.G) {
        int tid = F.tid; asm volatile("" : "+v"(tid)); const int lane = tid & 63, r32 = lane & 31, hi = lane >> 5;
        const bool gla = it >= 1024; const int ch = it & 1023, b = ch >> 9, h = (ch >> 7) & 3, n = ch & 127, t0 = b * SEQ + n * 128;
        const int mixoff = gla ? 768 : 0, goff = gla ? 2512 : 768;
        const float* gain = (gla ? F.in[18] : F.in[7]) + l * 256;
        if (gla) gla_cumsum_regs(R.la, Bc, tid);
        const float l2g = gla ? 0.f : ret_log2g(h);
        { const int t = tid >> 2, cq = (tid & 3) * 8;
          bf16x8 qa, qb, ka, kb, q2a, q2b;
          if (gla) {
#pragma unroll
              for (int j = 0; j < 8; ++j) {
                  const float bt0 = Bc[t * LB + cq + j], bm0 = Bc[63 * LB + cq + j], bt1 = Bc[t * LB + 32 + cq + j], bm1 = Bc[63 * LB + 32 + cq + j];
                  const float q0 = bf2f((bf16)R.q[0][j]) * 0.125f, q1 = bf2f((bf16)R.q[1][j]) * 0.125f, k0 = bf2f((bf16)R.k[0][j]), k1 = bf2f((bf16)R.k[1][j]);
                  q2a[j] = (short)f2bf(q0 * __expf(bt0)); qa[j] = (short)f2bf(q0 * __expf(bt0 - bm0)); ka[j] = (short)f2bf(k0 * __expf(bm0 - bt0));
                  q2b[j] = (short)f2bf(q1 * __expf(bt1)); qb[j] = (short)f2bf(q1 * __expf(bt1 - bm1)); kb[j] = (short)f2bf(k1 * __expf(bm1 - bt1)); }
          } else { const float xi = __builtin_amdgcn_exp2f((float)(t + 1) * l2g);
#pragma unroll
              for (int j = 0; j < 8; ++j) { const float cc = R.la[j >> 2][j & 3], sn = R.la[2 + (j >> 2)][j & 3];
                  const float x1 = bf2f((bf16)R.q[0][j]), x2 = bf2f((bf16)R.q[1][j]), y1 = bf2f((bf16)R.k[0][j]), y2 = bf2f((bf16)R.k[1][j]);
                  const float q0 = x1 * cc - x2 * sn, q1 = x1 * sn + x2 * cc, k0 = (y1 * cc - y2 * sn) * 0.125f, k1 = (y1 * sn + y2 * cc) * 0.125f;
                  qa[j] = (short)f2bf(q0); qb[j] = (short)f2bf(q1); ka[j] = (short)f2bf(k0); kb[j] = (short)f2bf(k1); q2a[j] = (short)f2bf(q0 * xi); q2b[j] = (short)f2bf(q1 * xi); } }
          *(bf16x8*)(Qs + t * LQ + cq) = qa; *(bf16x8*)(Qs + t * LQ + 32 + cq) = qb; *(bf16x8*)(Ks + t * LQ + cq) = ka; *(bf16x8*)(Ks + t * LQ + 32 + cq) = kb;
          *(bf16x8*)(Q2 + t * LQ + cq) = q2a; *(bf16x8*)(Q2 + t * LQ + 32 + cq) = q2b; }
        { const int s = tid & 127, cv = (tid >> 7) * 8;
#pragma unroll
          for (int j = 0; j < 8; ++j) { Vt[(cv + j) * LT + s] = (bf16)R.v[0][j]; Vt[(32 + cv + j) * LT + s] = (bf16)R.v[1][j]; } }
#pragma unroll
        for (int i = 0; i < 2; ++i) { const int idx = tid + 512 * i, v = idx >> 4, c4 = (idx & 15) * 4; const f32x4 sv = R.u[i];
            u32x2 w; w[0] = pk2(sv[0], sv[1]); w[1] = pk2(sv[2], sv[3]); *(u32x2*)(St + v * LQ + c4) = w; }
        __syncthreads();
        if (it + F.G < 2048) co_load(R, ws, it + F.G, tid);
        if (F.wave < 4) { const int tr = F.wave;
            unsigned gt[16];
#pragma unroll
            for (int r = 0; r < 16; ++r) { const bf16* gp = proj + (size_t)(t0 + 32 * tr + crow(r, hi)) * INP + goff + h * 64; gt[r] = (unsigned)gp[r32] | ((unsigned)gp[32 + r32] << 16); }
            const float gn0 = gain[h * 64 + r32], gn1 = gain[h * 64 + 32 + r32];
            f32x16 oi[2] = {};
            const int tl = 32 * tr + r32;
            for (int sj = 0; sj <= (tr >> 1); ++sj) {
                f32x16 p0 = {}, p1 = {};
#pragma unroll
                for (int ks = 0; ks < 4; ++ks) { const bf16x8 bq = *(const bf16x8*)(Qs + tl * LQ + 16 * ks + 8 * hi);
                    const bf16x8 a0 = *(const bf16x8*)(Ks + (64 * sj + r32) * LQ + 16 * ks + 8 * hi), a1 = *(const bf16x8*)(Ks + (64 * sj + 32 + r32) * LQ + 16 * ks + 8 * hi);
                    p0 = MFMA32(a0, bq, p0); p1 = MFMA32(a1, bq, p1); }
#pragma unroll
                for (int r = 0; r < 16; ++r) { const int s0 = 64 * sj + crow(r, hi), df0 = tl - s0, df1 = df0 - 32;
                    const float w0 = __builtin_amdgcn_exp2f((float)df0 * l2g), w1 = __builtin_amdgcn_exp2f((float)df1 * l2g);
                    p0[r] = df0 >= 0 ? p0[r] * w0 : 0.f; p1[r] = df1 >= 0 ? p1[r] * w1 : 0.f; }
#pragma unroll
                for (int q4 = 0; q4 < 4; ++q4) { const int st = (q4 & 1) * 8; u32x4 aw;
                    if (q4 < 2) { aw[0] = pk2(p0[st], p0[st + 1]); aw[1] = pk2(p0[st + 2], p0[st + 3]); aw[2] = pk2(p0[st + 4], p0[st + 5]); aw[3] = pk2(p0[st + 6], p0[st + 7]); }
                    else        { aw[0] = pk2(p1[st], p1[st + 1]); aw[1] = pk2(p1[st + 2], p1[st + 3]); aw[2] = pk2(p1[st + 4], p1[st + 5]); aw[3] = pk2(p1[st + 6], p1[st + 7]); }
                    const bf16x8 a = __builtin_bit_cast(bf16x8, aw); const int sb = 64 * sj + 16 * q4;
#pragma unroll
                    for (int vc = 0; vc < 2; ++vc) { const bf16* vp = Vt + (32 * vc + r32) * LT + sb + 4 * hi;
                        const s16x4 lo = *(const s16x4*)vp, hh = *(const s16x4*)(vp + 8);
                        const bf16x8 bv = {lo[0], lo[1], lo[2], lo[3], hh[0], hh[1], hh[2], hh[3]};
                        oi[vc] = MFMA32(a, bv, oi[vc]); } }
            }
#pragma unroll
            for (int ks = 0; ks < 4; ++ks) { const bf16x8 a = *(const bf16x8*)(Q2 + tl * LQ + 16 * ks + 8 * hi);
#pragma unroll
                for (int vc = 0; vc < 2; ++vc) { const bf16x8 bs = *(const bf16x8*)(St + (32 * vc + r32) * LQ + 16 * ks + 8 * hi); oi[vc] = MFMA32(a, bs, oi[vc]); } }
#pragma unroll
            for (int r = 0; r < 16; ++r) { const int tt = 32 * tr + crow(r, hi);
                const float o0 = oi[0][r], o1 = oi[1][r];
                float ss = o0 * o0 + o1 * o1;
                ss += __shfl_xor(ss, 1); ss += __shfl_xor(ss, 2); ss += __shfl_xor(ss, 4); ss += __shfl_xor(ss, 8); ss += __shfl_xor(ss, 16);
                const float rstd = rsqrtf(ss * (1.0f / 64.0f) + EPS);
                bf16* mp = mix + (size_t)(t0 + tt) * MIXK + mixoff + h * 64;
                mp[r32] = (bf16)f2bf(o0 * rstd * gn0 * silu(bflo(gt[r]))); mp[32 + r32] = (bf16)f2bf(o1 * rstd * gn1 * silu(bfhi(gt[r]))); }
        }
        __syncthreads();
    }
}
#define XB_TMO      128
#define XB_XCNT(j)  (256  + 64 * (j))
#define XB_XSUB(j)  (1280 + 64 * (j))
#define XB_XGEN(j)  (2304 + 64 * (j))
#define XB_TOP      3328
#define XB_TOPGEN   3392
#define XCD_BAR_WORDS 3456
#define XB_SPIN_CAP (1u << 18)

__device__ __forceinline__ unsigned xb_ld(unsigned* p)              { return __hip_atomic_load(p, __ATOMIC_RELAXED, __HIP_MEMORY_SCOPE_AGENT); }
__device__ __forceinline__ unsigned xb_add(unsigned* p, unsigned v) { return __hip_atomic_fetch_add(p, v, __ATOMIC_RELAXED, __HIP_MEMORY_SCOPE_AGENT); }
__device__ __forceinline__ unsigned xb_xcc_id() { return (unsigned)__builtin_amdgcn_s_getreg((3 << 11) | 20) & 0xFu; }
#define XB_SPIN(cond, bar) do { unsigned _sp = 0; while (cond) { __builtin_amdgcn_s_sleep(1); \
    if ((++_sp & 255u) == 0u) { if (xb_ld(&(bar)[XB_TMO])) break; if (_sp > XB_SPIN_CAP) { atomicAdd(&(bar)[XB_TMO], 1u); break; } } } } while (0)

struct XcdBarrier {
    unsigned* bar; unsigned x;
    volatile LAS unsigned* st;
};

__device__ __forceinline__ XcdBarrier xcd_barrier_post(unsigned* bar, volatile LAS unsigned* st) {
    XcdBarrier b; b.bar = bar; b.x = xb_xcc_id(); b.st = st;
    if (threadIdx.x == 0) (void)xb_add(&bar[XB_XCNT(b.x)], 1u);
    return b;
}
__device__ __forceinline__ void xcd_barrier_complete(unsigned* bar, unsigned x, unsigned& nloc, unsigned& nx) {
    const unsigned G = gridDim.x * gridDim.y * gridDim.z;
    unsigned sum, cnt, mine, sp = 0u;
    for (;;) {
        sum = 0u; cnt = 0u; mine = 0u;
#pragma unroll
        for (unsigned j = 0; j < 16; ++j) { const unsigned c = xb_ld(&bar[XB_XCNT(j)]); sum += c; cnt += (c > 0u) ? 1u : 0u; mine = (j == x) ? c : mine; }
        if (sum == G) break;
        __builtin_amdgcn_s_sleep(1);
        if ((++sp & 255u) == 0u) { if (xb_ld(&bar[XB_TMO])) break; if (sp > XB_SPIN_CAP) { atomicAdd(&bar[XB_TMO], 1u); break; } }
    }
    nloc = mine > 0u ? mine : 1u; nx = cnt > 0u ? cnt : 1u;
}

__device__ __forceinline__ void xcd_barrier(const XcdBarrier& b) {
    asm volatile("s_waitcnt vmcnt(0)" ::: "memory");
    __syncthreads();
    if (threadIdx.x == 0) {
        unsigned* bar = b.bar;
        __builtin_amdgcn_s_waitcnt(0);
        unsigned nloc = b.st[0], nx = b.st[1];
        if (nloc == 0u) { xcd_barrier_complete(bar, b.x, nloc, nx); b.st[0] = nloc; b.st[1] = nx; }
        const unsigned old = xb_add(&bar[XB_XSUB(b.x)], 1u);
        const unsigned gen = old / nloc;
        if (old + 1u == (gen + 1u) * nloc) {
            __builtin_amdgcn_fence(__ATOMIC_RELEASE, "agent");
            asm volatile("s_waitcnt vmcnt(0)" ::: "memory");
            const unsigned og = xb_add(&bar[XB_TOP], 1u);
            const unsigned tg = og / nx;
            if (og + 1u == (tg + 1u) * nx) xb_add(&bar[XB_TOPGEN], 1u);
            else XB_SPIN(xb_ld(&bar[XB_TOPGEN]) == tg, bar);
            __builtin_amdgcn_fence(__ATOMIC_ACQUIRE, "agent");
            xb_add(&bar[XB_XGEN(b.x)], 1u);
            asm volatile("s_waitcnt vmcnt(0)" ::: "memory");
        } else {
            XB_SPIN(xb_ld(&bar[XB_XGEN(b.x)]) == gen, bar);
            __builtin_amdgcn_fence(__ATOMIC_ACQUIRE, "agent");
            asm volatile("s_waitcnt vmcnt(0)" ::: "memory");
        }
    }
    __syncthreads();
}
__device__ __forceinline__ att::BlockRef mk_attn_ref(unsigned char* ws, unsigned char* ob, int L, int pass, bool dummy = false) {
    const int bh = L >> 5, x = L & 31, qb = pass ? x : 63 - x, b = bh >> 2, h = bh & 3;
    att::BlockRef r;
    r.Q = (const bf16*)(ob + OUT_QF) + (size_t)(b * SEQ + qb * 256) * 768 + h * 192;
    r.O = (bf16*)(ws + WS_MIX) + (size_t)(b * SEQ + qb * 256) * MIXK + 256 + h * 128;
    r.K = (const bf16*)(ob + OUT_KV) + (size_t)(b * SEQ) * 1024 + h * 256;
    r.KR = (const bf16*)(ws + WS_KROPE) + (size_t)(b * SEQ) * 64;
    r.P0 = qb * 256; r.tok0 = b * SEQ + qb * 256;
    return r;
}
__device__ __forceinline__ void attn_phase(Frame& F, int l, bool dummy = false) {
    const int G = F.G, vcu = (G % 8 == 0) ? (F.bid % 8) * (G / 8) + F.bid / 8 : F.bid;
    float gq = 0.f, gr = 0.f, gk = 0.f, gkr = 0.f;
    { const float* a = F.in[12] + l * 128; const float* b = F.in[13] + l * 64; const float* c = F.in[14] + l * 128; const float* d = F.in[15] + l * 64;
      gq = fmaxf(fabsf(a[F.lane]), fabsf(a[64 + F.lane])); gk = fmaxf(fabsf(c[F.lane]), fabsf(c[64 + F.lane])); gr = fabsf(b[F.lane]); gkr = fabsf(d[F.lane]);
#pragma unroll
      for (int o = 1; o < 64; o <<= 1) { gq = fmaxf(gq, __shfl_xor(gq, o)); gk = fmaxf(gk, __shfl_xor(gk, o)); gr = fmaxf(gr, __shfl_xor(gr, o)); gkr = fmaxf(gkr, __shfl_xor(gkr, o)); } }
    const float bound = 1.03f * att::SCALE * sqrtf(128.f * gq * gq + 64.f * gr * gr) * sqrtf(128.f * gk * gk + 64.f * gkr * gkr);
    const float mB = bound * 1.4426950408889634f;
    att::QNorm qn; qn.gqn = F.in[12] + l * 128; qn.gkn = F.in[14] + l * 128; qn.gqr = F.in[13] + l * 64; qn.rc = (const float*)(F.ws + WS_ROPE); qn.rsn = qn.rc + (size_t)M * 32;
    const bool use_static = bound < 40.0f;
    for (int L = vcu; L < 256; L += G)
        for (int pass = 0; pass < 2; ++pass) { const att::BlockRef cur = mk_attn_ref(F.ws, (unsigned char*)F.out, L, pass, dummy);
            if (use_static) att::attn_block<true>(cur, (char*)F.lds, mB, qn); else att::attn_block<false>(cur, (char*)F.lds, mB, qn); }
}

__global__ void __launch_bounds__(NTHREADS) mega_fwd(Params p) {
    extern __shared__ __attribute__((aligned(16))) unsigned char lds[];
    cg::grid_group grid = cg::this_grid();
    PG8_LAS unsigned char* ring = (PG8_LAS unsigned char*)lds;
    volatile LAS unsigned* bst = (volatile LAS unsigned*)((LAS unsigned char*)lds + 131072 + 256);
    if (threadIdx.x < 2) bst[threadIdx.x] = 0u;
    __syncthreads();
    XcdBarrier xbar = xcd_barrier_post((unsigned*)(p.ws + WS_CTL), bst);
    int rep = 0; (void)rep;
#if PROBE_SYNC
    for (int i = 0; i < PROBE_SYNC; ++i) xcd_barrier(xbar);
#endif
    for (int ph = p.ph_lo; ph < p.ph_hi; ++ph) {
        int tid_ = threadIdx.x, bid_ = blockIdx.x, G_ = gridDim.x;
        __attribute__((address_space(1))) unsigned char* wsg = (__attribute__((address_space(1))) unsigned char*)p.ws; __attribute__((address_space(1))) float* outg = (__attribute__((address_space(1))) float*)p.out;
        asm volatile("" : "+v"(tid_)); asm volatile("" : "+s"(bid_)); asm volatile("" : "+s"(G_)); asm volatile("" : "+s"(wsg)); asm volatile("" : "+s"(outg));
        unsigned char* ws = (unsigned char*)wsg; float* out_ = (float*)outg;
        Frame F; F.lds = lds; F.tid = tid_; F.lane = F.tid & 63; F.wave = __builtin_amdgcn_readfirstlane(F.tid >> 6); F.G = G_; F.bid = bid_;
#pragma unroll
        for (int i = 0; i < 23; ++i) F.in[i] = (const float*)(const __attribute__((address_space(1))) float*)p.in[i];
        F.out = out_; F.ws = ws;
        bf16* xb = (bf16*)(ws + WS_XB); bf16* actb = (bf16*)(ws + WS_A); float* ssq = (float*)(ws + WS_SSQ); bf16* mix = (bf16*)(ws + WS_MIX);
        const int l = ph / PH_PER_LAYER, q = ph % PH_PER_LAYER;
#ifndef PH_MASK
#define PH_MASK 0x7ff
#endif
#define PHON(k) ((PH_MASK >> (k)) & 1)
        if (q == 0) { if (PHON(0)) prep_phase(F, l); }
        else if (PHON(1) && (q == 1 || q == 9)) {
            pg8::Gemm g{xb, (const bf16*)(ws + (q == 1 ? WS_W1 : WS_W3)), M, 2 * DFF, D};
            pg8::StaticOrder S; S.init(M, 2 * DFF, F.G, F.bid);
            pg8::EpiSwiGLU E{actb, ssq, DFF};
            pg8::gemm_phase<pg8::EpiSwiGLU, pg8::StaticOrder, true, true>(ring, g, S, E);
#if PROBE_FFNUP
            grid.sync(); pg8::gemm_phase<pg8::EpiSwiGLU, pg8::StaticOrder, true, true>(ring, g, S, E);
#endif
        } else if (PHON(2) && (q == 2 || q == 8 || q == 10)) {
            const bf16* A = q == 8 ? mix : actb; const bf16* Bt = (const bf16*)(ws + (q == 2 ? WS_W2 : q == 8 ? WS_WOUT : WS_W4)); const int K = q == 8 ? MIXK : DFF;
            pg8::Gemm g{A, Bt, M, D, K};
            pg8::StaticOrder S; S.init(M, D, F.G, F.bid);
            pg8::EpiResid E{(ph == NPHASE - 1) ? F.out : nullptr, xb, ssq, q == 8 ? 1.0f : 0.5f};
            pg8::gemm_phase<pg8::EpiResid, pg8::StaticOrder, true, true>(ring, g, S, E);
        } else if (PHON(3) && (q == 3 || q == 5)) {
            const int nj = q == 5 ? 3 : 1;
            for (int j = 0; j < nj; ++j) {
                pg8::Gemm g; pg8::EpiPlain E; int oid = F.bid;
                if (q == 3)      { g = pg8::Gemm{xb, (const bf16*)(ws + WS_WIN), M, INP - 256, D};                       E = pg8::EpiPlain{actb, INP, 0, ssq, nullptr, nullptr}; }
                else if (j == 0) { g = pg8::Gemm{(const bf16*)(ws + WS_CQN), (const bf16*)(ws + WS_WUQ), M, 768, 384};    E = pg8::EpiPlain{(bf16*)((unsigned char*)F.out + OUT_QF), 768, 0, nullptr, nullptr, nullptr}; }
                else if (j == 1) { g = pg8::Gemm{(const bf16*)(ws + WS_CKVN), (const bf16*)(ws + WS_WUKV), M, 1024, 256}; E = pg8::EpiPlain{(bf16*)((unsigned char*)F.out + OUT_KV), 1024, 0, nullptr, F.in[14] + l * 128, (PG8_LAS float*)((PG8_LAS unsigned char*)lds + 131072 + 1024)}; }
                else             { g = pg8::Gemm{xb, (const bf16*)(ws + WS_WIN) + (size_t)(INP - 256) * D, M, 256, D};   E = pg8::EpiPlain{actb, INP, INP - 256, ssq, nullptr, nullptr}; oid = (F.bid + F.G / 2) % F.G; }
                pg8::StaticOrder S; S.init(M, g.N, F.G, oid);
                pg8::gemm_phase<pg8::EpiPlain, pg8::StaticOrder, true, true>(ring, g, S, E);
            }
            if (PHON(5) && q == 5) { __syncthreads(); chunk_state_phase(F); }
        } else if (PHON(4) && q == 4) post1_phase(F, l);
        else if (PHON(6) && q == 6) { scan_phase(F); }
        else if (q == 7) { if (PHON(7)) { chunk_out_phase(F, l);
#if PROBE_CO
            xcd_barrier(xbar); chunk_out_phase(F, l);
#endif
            } __syncthreads();
#if PROBE_ATTN
            grid.sync(); attn_phase(F, l, true);
#endif
            if (PHON(8)) attn_phase(F, l); }
#if PROBE_REP
        if ((PROBE_REP >> q) & 1) { if (rep == 0) { rep = 1; grid.sync(); --ph; continue; } rep = 0; }
#endif
        if (ph + 1 < p.ph_hi) { if (ph == p.ph_lo) grid.sync(); else xcd_barrier(xbar); }
    }
}

extern "C" void kernel_launch(void* const* d_in, const int* in_sizes, int n_in, void* d_out, int out_size, void* d_ws, size_t ws_size, hipStream_t stream) {
    static int grid = 0;
    if (grid == 0) {
        if (n_in != 23 || in_sizes[0] != M * D || out_size != M * D || ws_size < WS_END) { fprintf(stderr, "kernel_launch: unexpected shapes (n_in %d, in0 %d, out %d, ws %zu; need ws >= %zu)\n", n_in, n_in > 0 ? in_sizes[0] : -1, out_size, ws_size, (size_t)WS_END); grid = -1; return; }
        int dev = 0, cus = 0, per_cu = 0;
        (void)hipGetDevice(&dev); (void)hipDeviceGetAttribute(&cus, hipDeviceAttributeMultiprocessorCount, dev);
        if (hipFuncSetAttribute((const void*)mega_fwd, hipFuncAttributeMaxDynamicSharedMemorySize, LDS_BYTES) != hipSuccess) fprintf(stderr, "kernel_launch: hipFuncSetAttribute failed\n");
        if (hipOccupancyMaxActiveBlocksPerMultiprocessor(&per_cu, (const void*)mega_fwd, NTHREADS, LDS_BYTES) != hipSuccess || per_cu < 1) { fprintf(stderr, "kernel_launch: occupancy query gave %d; using 1\n", per_cu); per_cu = 1; }
        (void)hipGetLastError();
        if (cus <= 0) cus = 256;
        grid = cus * per_cu;
    }
    if (grid < 0) return;
    Params p{};
    for (int i = 0; i < 23; ++i) p.in[i] = (const float*)d_in[i];
    p.out = (float*)d_out; p.ws = (unsigned char*)d_ws;
#if ONE_LAUNCH
    if (hipMemsetAsync((char*)d_ws + WS_CTL, 0, CTL_BYTES, stream) != hipSuccess) fprintf(stderr, "kernel_launch: hipMemsetAsync failed\n");
    p.ph_lo = 0; p.ph_hi = NPHASE;
    void* args[] = {&p};
    hipError_t e = hipLaunchCooperativeKernel((const void*)mega_fwd, dim3(grid), dim3(NTHREADS), args, LDS_BYTES, stream);
    if (e != hipSuccess) fprintf(stderr, "kernel_launch: cooperative launch failed: %s (grid %d)\n", hipGetErrorString(e), grid);
#else
    for (int ph = 0; ph < NPHASE; ++ph) { p.ph_lo = ph; p.ph_hi = ph + 1; hipLaunchKernelGGL(mega_fwd, dim3(grid), dim3(NTHREADS), LDS_BYTES, stream, p); }
#endif
}
```
